# Optimizing an MI355X kernel written in HIP

```python
import math
import jax, jax.numpy as jnp
from jax import lax
import numpy as np


D_MODEL = 2048
BATCH = 1
SEQ = 8192
DEPTH = 2
DEC_BATCH = 128
DEC_SEQ = 8
PAST_LEN = 2048
PAGE_SIZE = 128

N_A_LAYERS = DEPTH // 2
N_B_LAYERS = DEPTH - N_A_LAYERS
SSM_GROUP = 16
SSM_GROUPS = D_MODEL // SSM_GROUP
SSM_STATE = 64
HEAD_DIM = 128
N_HEADS = D_MODEL // HEAD_DIM
N_KV_HEADS = 4
Q_PER_KV = N_HEADS // N_KV_HEADS
D_FF = 4 * D_MODEL
PLE_DIM = 256
BLOCK_Q = 128
LN_EPS = 1e-5
DN_ALPHA = (2.0 * DEPTH) ** 0.25
DN_BETA = (8.0 * DEPTH) ** -0.25
DT_MIN = 0.001
DT_MAX = 0.1
SB_BIAS_INIT = -6.0

kernel_name = 'yoco_s5_stickbreaking_decoder_step'


def layer_norm(x, g, b):
    xf = x.astype(jnp.float32)
    mu = jnp.mean(xf, axis=-1, keepdims=True)
    var = jnp.mean(jnp.square(xf - mu), axis=-1, keepdims=True)
    return ((xf - mu) * lax.rsqrt(var + LN_EPS) * g.astype(jnp.float32) + b.astype(jnp.float32)).astype(x.dtype)


def post_norm(x, sub, g, b):
    return layer_norm(DN_ALPHA * x + sub.astype(x.dtype), g, b)


def _ssm_combine(e1, e2):
    a1r, a1i, b1r, b1i = e1
    a2r, a2i, b2r, b2i = e2
    return (a1r * a2r - a1i * a2i,
            a1r * a2i + a1i * a2r,
            a2r * b1r - a2i * b1i + b2r,
            a2r * b1i + a2i * b1r + b2i)


def s5_mixer(x, h0_re, h0_im, lam_re, lam_im, log_dt, b_re, b_im, c_re, c_im, d_skip, w_gate, w_out):
    bsz, t, _ = x.shape
    f32 = jnp.float32
    lam_re = lam_re.astype(f32)
    lam_im = lam_im.astype(f32)
    dt = jnp.exp(log_dt.astype(f32))[:, None]
    mag = jnp.exp(lam_re * dt)
    ang = lam_im * dt
    ab_re = mag * jnp.cos(ang)
    ab_im = mag * jnp.sin(ang)
    den = lam_re * lam_re + lam_im * lam_im
    nr = ab_re - 1.0
    f_re = (nr * lam_re + ab_im * lam_im) / den
    f_im = (ab_im * lam_re - nr * lam_im) / den
    b_re = b_re.astype(f32)
    b_im = b_im.astype(f32)
    bb_re = f_re[..., None] * b_re - f_im[..., None] * b_im
    bb_im = f_re[..., None] * b_im + f_im[..., None] * b_re
    u = x.astype(f32).reshape(bsz, t, SSM_GROUPS, SSM_GROUP)
    bu_re = jnp.einsum('btgc,gpc->btgp', u, bb_re)
    bu_im = jnp.einsum('btgc,gpc->btgp', u, bb_im)
    a_re = jnp.broadcast_to(ab_re, bu_re.shape)
    a_im = jnp.broadcast_to(ab_im, bu_im.shape)
    acum_re, acum_im, h_re, h_im = lax.associative_scan(
        _ssm_combine, (a_re, a_im, bu_re, bu_im), axis=1)
    h0r = h0_re.astype(f32)[:, None]
    h0i = h0_im.astype(f32)[:, None]
    h_re, h_im = (h_re + acum_re * h0r - acum_im * h0i,
                  h_im + acum_re * h0i + acum_im * h0r)
    y = (jnp.einsum('btgp,gcp->btgc', h_re, c_re.astype(f32))
         - jnp.einsum('btgp,gcp->btgc', h_im, c_im.astype(f32)))
    y = y.reshape(bsz, t, D_MODEL) + d_skip.astype(f32) * x.astype(f32)
    g = jax.nn.gelu(y).astype(x.dtype)
    out = (g * jax.nn.sigmoid(g @ w_gate)) @ w_out
    return out, h_re[:, -1], h_im[:, -1]


def _sb_block(q, k, v, q_pos, k_pos, bias):
    bsz, qb, _, _ = q.shape
    f32 = jnp.float32
    qg = q.astype(f32).reshape(bsz, qb, N_KV_HEADS, Q_PER_KV, HEAD_DIM)
    z = jnp.einsum('bqhgd,bkhd->bhgqk', qg, k.astype(f32)) * (HEAD_DIM ** -0.5)
    z = z + bias.astype(f32).reshape(N_KV_HEADS, Q_PER_KV)[None, :, :, None, None]
    causal = k_pos[None, :] < q_pos[:, None]
    log_stay = jnp.where(causal, jax.nn.log_sigmoid(-z), 0.0)
    log_w = jax.nn.log_sigmoid(z) + lax.cumsum(log_stay, axis=4, reverse=True) - log_stay
    w = jnp.where(causal, jnp.exp(log_w), 0.0)
    o = jnp.einsum('bhgqk,bkhd->bqhgd', w, v.astype(f32))
    return o.reshape(bsz, qb, N_HEADS, HEAD_DIM).astype(v.dtype)


def stick_breaking_attention(q, k, v, q_pos, k_pos, bias):
    bsz, t, h, d = q.shape
    qb = BLOCK_Q if t % BLOCK_Q == 0 else t
    nb = t // qb
    q_blocks = q.reshape(bsz, nb, qb, h, d).transpose(1, 0, 2, 3, 4)
    pos_blocks = q_pos.reshape(nb, qb)
    out = lax.map(lambda a: _sb_block(a[0], k, v, a[1], k_pos, bias), (q_blocks, pos_blocks))
    return out.transpose(1, 0, 2, 3, 4).reshape(bsz, t, h, d)


def squared_relu_mlp(x, w1, w2):
    return jnp.square(jax.nn.relu(x @ w1)) @ w2


def per_layer_embedding(x, p, w_proj, w_gate):
    return (p.astype(x.dtype) @ w_proj) * jax.nn.sigmoid(x @ w_gate)


def run_trunk(x, p, h0_re, h0_im, k_past, v_past, pos0, P):
    bsz, t, _ = x.shape
    q_pos = pos0 + jnp.arange(t)
    k_pos = jnp.arange(pos0 + t)
    new_re, new_im = [], []
    k_new = v_new = k_all = v_all = None
    for i in range(DEPTH):
        if i < N_A_LAYERS:
            mix, hr, hi = s5_mixer(x, h0_re[i], h0_im[i], P['s5_lam_re'][i], P['s5_lam_im'][i],
                                   P['s5_log_dt'][i], P['s5_b_re'][i], P['s5_b_im'][i],
                                   P['s5_c_re'][i], P['s5_c_im'][i], P['s5_d'][i],
                                   P['s5_w_gate'][i], P['s5_w_out'][i])
            new_re.append(hr)
            new_im.append(hi)
        else:
            if i == N_A_LAYERS:
                k_new = (x @ P['w_k']).reshape(bsz, t, N_KV_HEADS, HEAD_DIM)
                v_new = (x @ P['w_v']).reshape(bsz, t, N_KV_HEADS, HEAD_DIM)
                k_all = jnp.concatenate([k_past.astype(k_new.dtype), k_new], axis=1)
                v_all = jnp.concatenate([v_past.astype(v_new.dtype), v_new], axis=1)
            j = i - N_A_LAYERS
            q = (x @ P['sb_w_q'][j]).reshape(bsz, t, N_HEADS, HEAD_DIM)
            o = stick_breaking_attention(q, k_all, v_all, q_pos, k_pos, P['sb_bias'][j])
            mix = o.reshape(bsz, t, N_HEADS * HEAD_DIM) @ P['sb_w_o'][j]
        x = post_norm(x, mix, P['ln_mix_g'][i], P['ln_mix_b'][i])
        x = post_norm(x, squared_relu_mlp(x, P['mlp_w1'][i], P['mlp_w2'][i]),
                      P['ln_mlp_g'][i], P['ln_mlp_b'][i])
        x = post_norm(x, per_layer_embedding(x, p[i], P['ple_w_proj'][i], P['ple_w_gate'][i]),
                      P['ln_ple_g'][i], P['ln_ple_b'][i])
    return x, jnp.stack(new_re), jnp.stack(new_im), k_new, v_new


def setup_inputs(seed: int = 0) -> dict:
    key = jax.random.key(seed)
    ks = jax.random.split(key, 40)
    f32 = jnp.float32

    def dense(k, shape, fan_in, scale=1.0):
        return jax.random.normal(k, shape, f32) * (scale * fan_in ** -0.5)

    n_pages = PAST_LEN // PAGE_SIZE
    n_used = DEC_BATCH * n_pages
    n_phys = (5 * n_used + 3) // 4
    page_table = jax.random.permutation(ks[8], n_phys)[:n_used].reshape(DEC_BATCH, n_pages).astype(jnp.int32)
    state_shape = (N_A_LAYERS, DEC_BATCH, SSM_GROUPS, SSM_STATE)
    gp = (N_A_LAYERS, SSM_GROUPS, SSM_STATE)
    return {
        'x_prompt': jax.random.normal(ks[0], (BATCH, SEQ, D_MODEL), f32),
        'x_sample': jax.random.normal(ks[1], (DEC_BATCH, DEC_SEQ, D_MODEL), f32),
        'p_prompt': jax.random.normal(ks[2], (DEPTH, BATCH, SEQ, PLE_DIM), f32),
        'p_sample': jax.random.normal(ks[3], (DEPTH, DEC_BATCH, DEC_SEQ, PLE_DIM), f32),
        'state_ssm_re': 0.1 * jax.random.normal(ks[4], state_shape, f32),
        'state_ssm_im': 0.1 * jax.random.normal(ks[5], state_shape, f32),
        'cache_k': jax.random.normal(ks[6], (n_phys, PAGE_SIZE, N_KV_HEADS, HEAD_DIM), f32),
        'cache_v': DN_BETA * jax.random.normal(ks[7], (n_phys, PAGE_SIZE, N_KV_HEADS, HEAD_DIM), f32),
        'page_table': page_table,
        's5_lam_re': -0.5 + 0.01 * jax.random.normal(ks[9], gp, f32),
        's5_lam_im': math.pi * jnp.arange(SSM_STATE, dtype=f32) + 0.01 * jax.random.normal(ks[10], gp, f32),
        's5_log_dt': jax.random.uniform(ks[11], (N_A_LAYERS, SSM_GROUPS), f32,
                                        math.log(DT_MIN), math.log(DT_MAX)),
        's5_b_re': dense(ks[12], (N_A_LAYERS, SSM_GROUPS, SSM_STATE, SSM_GROUP), 2 * SSM_GROUP),
        's5_b_im': dense(ks[13], (N_A_LAYERS, SSM_GROUPS, SSM_STATE, SSM_GROUP), 2 * SSM_GROUP),
        's5_c_re': dense(ks[14], (N_A_LAYERS, SSM_GROUPS, SSM_GROUP, SSM_STATE), SSM_STATE),
        's5_c_im': dense(ks[15], (N_A_LAYERS, SSM_GROUPS, SSM_GROUP, SSM_STATE), SSM_STATE),
        's5_d': jax.random.normal(ks[16], (N_A_LAYERS, D_MODEL), f32),
        's5_w_gate': dense(ks[17], (N_A_LAYERS, D_MODEL, D_MODEL), D_MODEL),
        's5_w_out': dense(ks[18], (N_A_LAYERS, D_MODEL, D_MODEL), D_MODEL, DN_BETA),
        'w_k': dense(ks[19], (D_MODEL, N_KV_HEADS * HEAD_DIM), D_MODEL),
        'w_v': dense(ks[20], (D_MODEL, N_KV_HEADS * HEAD_DIM), D_MODEL, DN_BETA),
        'sb_w_q': dense(ks[21], (N_B_LAYERS, D_MODEL, N_HEADS * HEAD_DIM), D_MODEL),
        'sb_w_o': dense(ks[22], (N_B_LAYERS, N_HEADS * HEAD_DIM, D_MODEL), N_HEADS * HEAD_DIM, DN_BETA),
        'sb_bias': SB_BIAS_INIT + 0.1 * jax.random.normal(ks[33], (N_B_LAYERS, N_HEADS), f32),
        'ln_mix_g': 1.0 + 0.02 * jax.random.normal(ks[23], (DEPTH, D_MODEL), f32),
        'ln_mix_b': 0.02 * jax.random.normal(ks[24], (DEPTH, D_MODEL), f32),
        'mlp_w1': dense(ks[25], (DEPTH, D_MODEL, D_FF), D_MODEL),
        'mlp_w2': dense(ks[26], (DEPTH, D_FF, D_MODEL), D_FF, DN_BETA),
        'ln_mlp_g': 1.0 + 0.02 * jax.random.normal(ks[27], (DEPTH, D_MODEL), f32),
        'ln_mlp_b': 0.02 * jax.random.normal(ks[28], (DEPTH, D_MODEL), f32),
        'ple_w_proj': dense(ks[29], (DEPTH, PLE_DIM, D_MODEL), PLE_DIM, DN_BETA),
        'ple_w_gate': dense(ks[30], (DEPTH, D_MODEL, D_MODEL), D_MODEL),
        'ln_ple_g': 1.0 + 0.02 * jax.random.normal(ks[31], (DEPTH, D_MODEL), f32),
        'ln_ple_b': 0.02 * jax.random.normal(ks[32], (DEPTH, D_MODEL), f32),
    }


def reference(x_prompt, x_sample, p_prompt, p_sample, state_ssm_re, state_ssm_im, cache_k, cache_v,
              page_table, s5_lam_re, s5_lam_im, s5_log_dt, s5_b_re, s5_b_im, s5_c_re, s5_c_im, s5_d,
              s5_w_gate, s5_w_out, w_k, w_v, sb_w_q, sb_w_o, sb_bias, ln_mix_g, ln_mix_b, mlp_w1, mlp_w2,
              ln_mlp_g, ln_mlp_b, ple_w_proj, ple_w_gate, ln_ple_g, ln_ple_b):
    params = dict(s5_lam_re=s5_lam_re, s5_lam_im=s5_lam_im, s5_log_dt=s5_log_dt, s5_b_re=s5_b_re,
                  s5_b_im=s5_b_im, s5_c_re=s5_c_re, s5_c_im=s5_c_im, s5_d=s5_d, s5_w_gate=s5_w_gate,
                  s5_w_out=s5_w_out, w_k=w_k, w_v=w_v, sb_w_q=sb_w_q, sb_w_o=sb_w_o, sb_bias=sb_bias,
                  ln_mix_g=ln_mix_g, ln_mix_b=ln_mix_b, mlp_w1=mlp_w1, mlp_w2=mlp_w2,
                  ln_mlp_g=ln_mlp_g, ln_mlp_b=ln_mlp_b, ple_w_proj=ple_w_proj, ple_w_gate=ple_w_gate,
                  ln_ple_g=ln_ple_g, ln_ple_b=ln_ple_b)
    n_dec, n_pages = page_table.shape
    past_len = n_pages * cache_k.shape[1]
    k_past = cache_k[page_table].reshape(n_dec, past_len, N_KV_HEADS, HEAD_DIM)
    v_past = cache_v[page_table].reshape(n_dec, past_len, N_KV_HEADS, HEAD_DIM)
    bsz = x_prompt.shape[0]
    h0 = jnp.zeros((N_A_LAYERS, bsz, SSM_GROUPS, SSM_STATE), jnp.float32)
    empty = jnp.zeros((bsz, 0, N_KV_HEADS, HEAD_DIM), x_prompt.dtype)
    y_prompt, sre_p, sim_p, k_p, v_p = run_trunk(x_prompt, p_prompt, h0, h0, empty, empty, 0, params)
    y_sample, sre_s, sim_s, k_s, v_s = run_trunk(x_sample, p_sample, state_ssm_re, state_ssm_im,
                                                 k_past, v_past, past_len, params)
    return (y_prompt, y_sample, sre_p, sim_p, k_p, v_p, sre_s, sim_s, k_s, v_s)
```

```cpp
#include <hip/hip_runtime.h>
#include <cstdio>
#include <cstdint>
namespace pg8 {
#define PG8_LAS __attribute__((address_space(3)))
typedef unsigned short bf16_t;
typedef short bf16x8 __attribute__((ext_vector_type(8)));
typedef float f32x4 __attribute__((ext_vector_type(4)));
typedef unsigned u32x4 __attribute__((ext_vector_type(4)));
constexpr int BM = 256, BK = 64, HALF = 128, HTB = HALF * BK * 2  , STAGE_BYTES = 8 * HTB, NXCD = 8, WGM = 8;

__host__ __device__ __forceinline__ int lds_byte(int r, int c) { const int st = (r >> 4) * 2 + (c >> 5), rr = r & 15, cc = c & 31, ob = rr * 64 + cc * 2; return st * 1024 + (ob ^ (((ob >> 9) & 1) << 5)); }
__host__ __device__ __forceinline__ void stage_rc(int b, int& R, int& C) { const int st = b / 1024, sb = b % 1024, swz = sb ^ (((sb >> 9) & 1) << 5); R = (st >> 1) * 16 + swz / 64; C = (st & 1) * 32 + (swz % 64) / 2; }
__host__ __device__ __forceinline__ int perm32(int rho) { const int n = rho >> 4, i = rho & 15; return 8 * (i >> 2) + 4 * n + (i & 3); }

struct Unit { int pm, pn; };
struct Gemm { const bf16_t* A; const bf16_t* Bt; int M, N, K; };

struct StaticOrder {
    int nM, nN, nwg, G, c;
    __host__ __device__ void init(int M, int N, int G_, int c_) { nM = M / BM; nN = N / BM; nwg = nM * nN; G = G_; c = c_; }
    __host__ __device__ bool next(int i, Unit& u) const {
        const long L = (long)i * G + c; if (L >= nwg) return false;
        int wgid = (int)L; { const int q = nwg / NXCD, r = nwg % NXCD, xcd = wgid % NXCD, off = wgid / NXCD; wgid = (xcd < r ? xcd * (q + 1) : r * (q + 1) + (xcd - r) * q) + off; }
        const int nig = WGM * nN, gid = wgid / nig, fm = gid * WGM, gsz = (nM - fm) < WGM ? (nM - fm) : WGM;
        u.pm = fm + ((wgid % nig) % gsz); u.pn = (wgid % nig) / gsz; return true;
    }
    __device__ __forceinline__ void a_ready(const Unit&) const {}
    __device__ __forceinline__ void done(const Unit&) const {}
};

__device__ __forceinline__ unsigned cvt_pk_bf16(float lo, float hi) { unsigned r; asm volatile("v_cvt_pk_bf16_f32 %0, %1, %2" : "=v"(r) : "v"(lo), "v"(hi)); return r; }
typedef float f32x2 __attribute__((ext_vector_type(2)));
typedef unsigned u32x2 __attribute__((ext_vector_type(2)));
__device__ __forceinline__ float bf_lo(unsigned w) { return __uint_as_float(w << 16); }
__device__ __forceinline__ float bf_hi(unsigned w) { return __uint_as_float(w & 0xffff0000u); }
__device__ __forceinline__ float sigm(float x) { return __builtin_amdgcn_rcpf(1.f + __expf(-x)); }
__device__ __forceinline__ u32x2 pack4(f32x4 v) { u32x2 w; w.x = cvt_pk_bf16(v[0], v[1]); w.y = cvt_pk_bf16(v[2], v[3]); return w; }
__host__ __device__ __forceinline__ int perm16(int k) { return (k & 3) | (((k >> 3) & 1) << 2) | (((k >> 2) & 1) << 3); }

struct EpiGate { static constexpr bool PERM = true, AFTER_DRAIN = false; const bf16_t* Gm; bf16_t* O; int ldc;
    __device__ __forceinline__ void operator()(const f32x4 (&acc)[2][2][4][2], const Unit& u, int wr, int wc, int fr, int fq) const {
        const int row0 = u.pm * BM + wr * 64 + fr, col0 = u.pn * BM + wc * 32 + 8 * fq;
#pragma unroll
        for (int ai = 0; ai < 2; ++ai)
#pragma unroll
            for (int m = 0; m < 4; ++m) { const size_t off = (size_t)(row0 + ai * HALF + m * 16) * ldc + col0;
#pragma unroll
                for (int bj = 0; bj < 2; ++bj) { const u32x4 g = *(const u32x4*)(Gm + off + bj * HALF); const f32x4 v0 = acc[ai][bj][m][0], v1 = acc[ai][bj][m][1];
                    u32x4 w;
                    w.x = cvt_pk_bf16(bf_lo(g.x) * sigm(v0[0]), bf_hi(g.x) * sigm(v0[1]));
                    w.y = cvt_pk_bf16(bf_lo(g.y) * sigm(v0[2]), bf_hi(g.y) * sigm(v0[3]));
                    w.z = cvt_pk_bf16(bf_lo(g.z) * sigm(v1[0]), bf_hi(g.z) * sigm(v1[1]));
                    w.w = cvt_pk_bf16(bf_lo(g.w) * sigm(v1[2]), bf_hi(g.w) * sigm(v1[3]));
                    *(u32x4*)(O + off + bj * HALF) = w; } }
    }
};
template <int ACT> struct EpiAct { static constexpr bool PERM = true, AFTER_DRAIN = false; bf16_t* O; int ldc;
    __device__ __forceinline__ void operator()(const f32x4 (&acc)[2][2][4][2], const Unit& u, int wr, int wc, int fr, int fq) const {
        const int row0 = u.pm * BM + wr * 64 + fr, col0 = u.pn * BM + wc * 32 + 8 * fq;
#pragma unroll
        for (int ai = 0; ai < 2; ++ai)
#pragma unroll
            for (int m = 0; m < 4; ++m) { const size_t off = (size_t)(row0 + ai * HALF + m * 16) * ldc + col0;
#pragma unroll
                for (int bj = 0; bj < 2; ++bj) { f32x4 v0 = acc[ai][bj][m][0], v1 = acc[ai][bj][m][1];
                    if (ACT == 1) {
#pragma unroll
                        for (int i = 0; i < 4; ++i) { const float a = fmaxf(v0[i], 0.f), b = fmaxf(v1[i], 0.f); v0[i] = a * a; v1[i] = b * b; } }
                    u32x4 w; w.x = cvt_pk_bf16(v0[0], v0[1]); w.y = cvt_pk_bf16(v0[2], v0[3]); w.z = cvt_pk_bf16(v1[0], v1[1]); w.w = cvt_pk_bf16(v1[2], v1[3]);
                    *(u32x4*)(O + off + bj * HALF) = w; } }
    }
};
struct EpiRes { static constexpr bool PERM = false, AFTER_DRAIN = false; const float* xlo; const float* xhi; float* R; int ldc; float alpha;
    __device__ __forceinline__ void operator()(const f32x4 (&acc)[2][2][4][2], const Unit& u, int wr, int wc, int fr, int fq) const {
        const float* X = (u.pm < 32) ? xlo : xhi; const int col0 = u.pn * BM + wc * 32 + 4 * fq;
#pragma unroll
        for (int ai = 0; ai < 2; ++ai)
#pragma unroll
            for (int m = 0; m < 4; ++m) { const size_t off = (size_t)(u.pm * BM + ai * HALF + wr * 64 + m * 16 + fr) * ldc + col0;
#pragma unroll
                for (int bj = 0; bj < 2; ++bj)
#pragma unroll
                    for (int n = 0; n < 2; ++n) { const f32x4 x = *(const f32x4*)(X + off + bj * HALF + n * 16); *(f32x4*)(R + off + bj * HALF + n * 16) = x * alpha + acc[ai][bj][m][n]; } }
    }
};
struct EpiPle { static constexpr bool PERM = false, AFTER_DRAIN = false; const float* X; const bf16_t* E; float* R; int ldc; float alpha;
    __device__ __forceinline__ void operator()(const f32x4 (&acc)[2][2][4][2], const Unit& u, int wr, int wc, int fr, int fq) const {
        const int col0 = u.pn * BM + wc * 32 + 4 * fq;
#pragma unroll
        for (int ai = 0; ai < 2; ++ai)
#pragma unroll
            for (int m = 0; m < 4; ++m) { const size_t off = (size_t)(u.pm * BM + ai * HALF + wr * 64 + m * 16 + fr) * ldc + col0;
#pragma unroll
                for (int bj = 0; bj < 2; ++bj)
#pragma unroll
                    for (int n = 0; n < 2; ++n) { const size_t o2 = off + bj * HALF + n * 16; const f32x4 x = *(const f32x4*)(X + o2); const u32x2 e = *(const u32x2*)(E + o2); const f32x4 a = acc[ai][bj][m][n];
                        f32x4 r; r[0] = x[0] * alpha + bf_lo(e.x) * sigm(a[0]); r[1] = x[1] * alpha + bf_hi(e.x) * sigm(a[1]); r[2] = x[2] * alpha + bf_lo(e.y) * sigm(a[2]); r[3] = x[3] * alpha + bf_hi(e.y) * sigm(a[3]);
                        *(f32x4*)(R + o2) = r; } }
    }
};
struct EpiKVQ { static constexpr bool PERM = false, AFTER_DRAIN = false; float* kp; float* ks; float* vp; float* vs; bf16_t* Kb; bf16_t* Vb; bf16_t* Vt; bf16_t* Qb; float qscale;
    __device__ __forceinline__ void operator()(const f32x4 (&acc)[2][2][4][2], const Unit& u, int wr, int wc, int fr, int fq) const {
        const bool prompt = u.pm < 32; const int colt = u.pn * BM + wc * 32 + 4 * fq;
#pragma unroll
        for (int ai = 0; ai < 2; ++ai)
#pragma unroll
            for (int m = 0; m < 4; ++m) { const int r = u.pm * BM + ai * HALF + wr * 64 + m * 16 + fr;
#pragma unroll
                for (int bj = 0; bj < 2; ++bj)
#pragma unroll
                    for (int n = 0; n < 2; ++n) { const int c = colt + bj * HALF + n * 16; const f32x4 v = acc[ai][bj][m][n];
                        if (u.pn < 2) {
                            float* dst = prompt ? kp + (size_t)r * 512 + c : ks + (size_t)(r - 8192) * 512 + c; *(f32x4*)dst = v;
                            if (prompt) *(u32x2*)(Kb + (size_t)r * 512 + c) = pack4(v);
                        } else if (u.pn < 4) { const int cc = c - 512;
                            float* dst = prompt ? vp + (size_t)r * 512 + cc : vs + (size_t)(r - 8192) * 512 + cc; *(f32x4*)dst = v;
                            if (prompt) { const u32x2 pk = pack4(v); *(u32x2*)(Vb + (size_t)r * 512 + cc) = pk; const int pr = (r & ~15) | perm16(r & 15);
                                Vt[(size_t)(cc + 0) * 8192 + pr] = (bf16_t)(pk.x & 0xffffu); Vt[(size_t)(cc + 1) * 8192 + pr] = (bf16_t)(pk.x >> 16);
                                Vt[(size_t)(cc + 2) * 8192 + pr] = (bf16_t)(pk.y & 0xffffu); Vt[(size_t)(cc + 3) * 8192 + pr] = (bf16_t)(pk.y >> 16); }
                        } else { const int qc = c - 1024; *(u32x2*)(Qb + (size_t)r * 2048 + qc) = pack4(v * qscale); } } }
    }
};

template <class Epi, class Sched, bool ALIGN_EPI = false, bool SP2 = false>
__device__ __forceinline__ void gemm_phase(PG8_LAS unsigned char* lds, const Gemm g, const Sched& S, const Epi& E) {
    const int tid = threadIdx.x, wid = __builtin_amdgcn_readfirstlane(tid >> 6), lane = tid & 63, wr = wid >> 2, wc = wid & 3, fr = lane & 15, fq = lane >> 4;
    const int K = g.K, nt = K / BK;
    unsigned voffA[2], voffB[2];
#pragma unroll
    for (int i = 0; i < 2; ++i) { int R, C; stage_rc(tid * 16 + i * 8192, R, C); const int Rb = Epi::PERM ? ((R & ~31) + perm32(R & 31)) : R;
        voffA[i] = (unsigned)(R * K + C) * 2u; voffB[i] = (unsigned)(Rb * K + C) * 2u; }
    const size_t kstep = (size_t)(BK * 2);
    const size_t hstep = (size_t)HALF * K * 2;
    const size_t tstep = 2 * hstep;
    const unsigned ldsw = (unsigned)wid * 1024u;
    const int aoff = lds_byte(wr * 64 + fr, fq * 8), boff = lds_byte(wc * 32 + fr, fq * 8);
#define PG8_SA(b, h) (((b) * 2 + (h)) * HTB)
#define PG8_SB(b, h) ((4 + (b) * 2 + (h)) * HTB)
#define PG8_STAGE(bufoff, gbase, voff) do { _Pragma("unroll") for (int _i = 0; _i < 2; ++_i) \
        __builtin_amdgcn_global_load_lds((const unsigned*)((const char*)(gbase) + (voff)[_i]), (PG8_LAS unsigned*)(lds + (bufoff) + ldsw + _i * 8192), 16, 0, 0); } while (0)
#define PG8_LDA(dst, b, h) do { _Pragma("unroll") for (int m = 0; m < 4; ++m) _Pragma("unroll") for (int k = 0; k < 2; ++k) dst[m][k] = *(const PG8_LAS bf16x8*)(lds + PG8_SA(b, h) + aoff + m * 2048 + k * 1024); } while (0)
#define PG8_LDB(dst, b, h) do { _Pragma("unroll") for (int n = 0; n < 2; ++n) _Pragma("unroll") for (int k = 0; k < 2; ++k) dst[n][k] = *(const PG8_LAS bf16x8*)(lds + PG8_SB(b, h) + boff + n * 2048 + k * 1024); } while (0)
#define PG8_MMA(ai, bj, At, Bt) do { __builtin_amdgcn_s_setprio(1); _Pragma("unroll") for (int m = 0; m < 4; ++m) _Pragma("unroll") for (int n = 0; n < 2; ++n) _Pragma("unroll") for (int k = 0; k < 2; ++k) \
        acc[ai][bj][m][n] = __builtin_amdgcn_mfma_f32_16x16x32_bf16(Bt[n][k], At[m][k], acc[ai][bj][m][n], 0, 0, 0); __builtin_amdgcn_s_setprio(0); } while (0)
#define PG8_WAIT_V(n) asm volatile("s_waitcnt vmcnt(" #n ")" ::: "memory")
#define PG8_WAIT_L(n) asm volatile("s_waitcnt lgkmcnt(" #n ")" ::: "memory")
#define PG8_BAR __builtin_amdgcn_s_barrier()
#define PG8_SCHED __builtin_amdgcn_sched_barrier(0)
    Unit cur, nxt; int ui = 0;
    if (!S.next(0, cur)) return;
    f32x4 acc[2][2][4][2];
#pragma unroll
    for (int a = 0; a < 2; ++a)
#pragma unroll
        for (int b = 0; b < 2; ++b)
#pragma unroll
            for (int m = 0; m < 4; ++m)
#pragma unroll
                for (int n = 0; n < 2; ++n) acc[a][b][m][n] = (f32x4){0.f, 0.f, 0.f, 0.f};
    bf16x8 At[4][2], B0[2][2], B1[2][2];
    const char* cA = (const char*)g.A + (size_t)cur.pm * tstep; const char* cB = (const char*)g.Bt + (size_t)cur.pn * tstep;
    S.a_ready(cur);
    if constexpr (SP2) {
        PG8_STAGE(PG8_SB(0, 0), cB, voffB); PG8_STAGE(PG8_SB(0, 1), cB + hstep, voffB); PG8_STAGE(PG8_SA(0, 0), cA, voffA); PG8_STAGE(PG8_SA(0, 1), cA + hstep, voffA);
        if (wr == 1) PG8_BAR;
        PG8_WAIT_V(2); PG8_BAR;
        PG8_STAGE(PG8_SB(1, 0), cB + kstep, voffB); PG8_STAGE(PG8_SA(1, 0), cA + kstep, voffA); PG8_STAGE(PG8_SB(1, 1), cB + hstep + kstep, voffB);
        PG8_WAIT_V(6); PG8_BAR;
    } else {
        PG8_STAGE(PG8_SB(0, 0), cB, voffB); PG8_STAGE(PG8_SA(0, 0), cA, voffA); PG8_STAGE(PG8_SB(0, 1), cB + hstep, voffB); PG8_STAGE(PG8_SA(0, 1), cA + hstep, voffA);
        if (wr == 1) PG8_BAR;
        PG8_WAIT_V(4); PG8_BAR;
        PG8_STAGE(PG8_SB(1, 0), cB + kstep, voffB); PG8_STAGE(PG8_SA(1, 0), cA + kstep, voffA); PG8_STAGE(PG8_SB(1, 1), cB + hstep + kstep, voffB);
        PG8_WAIT_V(6); PG8_BAR;
    }
    for (;;) {
        const bool has_next = S.next(ui + 1, nxt);
        const char* nA = has_next ? (const char*)g.A + (size_t)nxt.pm * tstep : cA; const char* nB = has_next ? (const char*)g.Bt + (size_t)nxt.pn * tstep : cB;
        for (int t = 0; t < nt; t += 2) {
            const bool last = (t == nt - 2);
            const char* a1 = cA + (size_t)(t + 1) * kstep;
            const char* a2 = last ? nA : cA + (size_t)(t + 2) * kstep; const char* b2 = last ? nB : cB + (size_t)(t + 2) * kstep;
            const char* a3 = a2 + kstep; const char* b3 = b2 + kstep;
            if (last && has_next) S.a_ready(nxt);
            if constexpr (SP2) {
            PG8_LDB(B0, 0, 0); PG8_LDB(B1, 0, 1); PG8_SCHED; PG8_LDA(At, 0, 0); PG8_STAGE(PG8_SA(1, 1), a1 + hstep, voffA);
            PG8_WAIT_V(8); PG8_WAIT_L(0); PG8_BAR; PG8_MMA(0, 0, At, B0); PG8_MMA(0, 1, At, B1); PG8_BAR; PG8_SCHED;
            PG8_LDA(At, 0, 1); PG8_STAGE(PG8_SB(0, 0), b2, voffB); PG8_STAGE(PG8_SB(0, 1), b2 + hstep, voffB); PG8_STAGE(PG8_SA(0, 0), a2, voffA);
            PG8_WAIT_V(8); PG8_WAIT_L(0); PG8_BAR; PG8_MMA(1, 0, At, B0); PG8_MMA(1, 1, At, B1); PG8_BAR; PG8_SCHED;
            PG8_LDB(B0, 1, 0); PG8_LDB(B1, 1, 1); PG8_SCHED; PG8_LDA(At, 1, 0); PG8_STAGE(PG8_SA(0, 1), a2 + hstep, voffA);
            PG8_WAIT_V(8); PG8_WAIT_L(0); PG8_BAR; PG8_MMA(0, 0, At, B0); PG8_MMA(0, 1, At, B1); PG8_BAR; PG8_SCHED;
            PG8_LDA(At, 1, 1); PG8_STAGE(PG8_SB(1, 0), b3, voffB); PG8_STAGE(PG8_SB(1, 1), b3 + hstep, voffB); PG8_STAGE(PG8_SA(1, 0), a3, voffA);
            PG8_WAIT_V(8); PG8_WAIT_L(0); PG8_BAR; PG8_MMA(1, 0, At, B0); PG8_MMA(1, 1, At, B1); PG8_BAR; PG8_SCHED;
            } else {
            PG8_LDB(B0, 0, 0); PG8_SCHED; PG8_LDA(At, 0, 0); PG8_STAGE(PG8_SA(1, 1), a1 + hstep, voffA);
            PG8_WAIT_L(8); PG8_BAR; PG8_WAIT_L(0); PG8_MMA(0, 0, At, B0); PG8_BAR; PG8_SCHED;
            PG8_LDB(B1, 0, 1); PG8_STAGE(PG8_SB(0, 0), b2, voffB);
            PG8_BAR; PG8_WAIT_L(0); PG8_MMA(0, 1, At, B1); PG8_BAR;
            PG8_LDA(At, 0, 1); PG8_STAGE(PG8_SA(0, 0), a2, voffA);
            PG8_BAR; PG8_WAIT_L(0); PG8_MMA(1, 0, At, B0); PG8_BAR; PG8_SCHED;
            PG8_STAGE(PG8_SB(0, 1), b2 + hstep, voffB);
            PG8_WAIT_V(6); PG8_BAR; PG8_MMA(1, 1, At, B1); PG8_BAR;
            PG8_LDB(B0, 1, 0); PG8_SCHED; PG8_LDA(At, 1, 0); PG8_STAGE(PG8_SA(0, 1), a2 + hstep, voffA);
            PG8_WAIT_L(8); PG8_BAR; PG8_WAIT_L(0); PG8_MMA(0, 0, At, B0); PG8_BAR; PG8_SCHED;
            PG8_LDB(B1, 1, 1); PG8_STAGE(PG8_SB(1, 0), b3, voffB);
            PG8_BAR; PG8_WAIT_L(0); PG8_MMA(0, 1, At, B1); PG8_BAR;
            PG8_LDA(At, 1, 1); PG8_STAGE(PG8_SA(1, 0), a3, voffA);
            PG8_BAR; PG8_WAIT_L(0); PG8_MMA(1, 0, At, B0); PG8_BAR; PG8_SCHED;
            PG8_STAGE(PG8_SB(1, 1), b3 + hstep, voffB);
            PG8_WAIT_V(6); PG8_BAR; PG8_MMA(1, 1, At, B1); PG8_BAR;
            }
        }
        if constexpr (ALIGN_EPI) { if (wr == 0) PG8_BAR; }
        if constexpr (!Epi::AFTER_DRAIN) { E(acc, cur, wr, wc, fr, fq); S.done(cur); }
        if (!has_next) break;
#pragma unroll
        for (int a = 0; a < 2; ++a)
#pragma unroll
            for (int b = 0; b < 2; ++b)
#pragma unroll
                for (int m = 0; m < 4; ++m)
#pragma unroll
                    for (int n = 0; n < 2; ++n) acc[a][b][m][n] = (f32x4){0.f, 0.f, 0.f, 0.f};
        cur = nxt; cA = nA; cB = nB; ++ui;
        if constexpr (ALIGN_EPI) { if (wr == 1) PG8_BAR; }
    }
    PG8_WAIT_V(0);
    if constexpr (!ALIGN_EPI) { if (wr == 0) PG8_BAR; }
    PG8_BAR;
    if constexpr (Epi::AFTER_DRAIN) { E.fused(acc, cur, wr, wc, fr, fq, lds, wid, lane); S.done(cur); }
#undef PG8_SA
#undef PG8_SB
#undef PG8_STAGE
#undef PG8_LDA
#undef PG8_LDB
#undef PG8_MMA
#undef PG8_WAIT_V
#undef PG8_WAIT_L
#undef PG8_BAR
#undef PG8_SCHED
}
}
#define GAS __attribute__((address_space(1)))
#define LAS __attribute__((address_space(3)))
typedef unsigned short bf16;
typedef unsigned v4u __attribute__((ext_vector_type(4)));
typedef float f32x4 __attribute__((ext_vector_type(4)));
typedef short bf16x8 __attribute__((ext_vector_type(8)));
typedef GAS unsigned gu32;
typedef GAS unsigned long long gu64;
#define RLX_AGENT __ATOMIC_RELAXED, __HIP_MEMORY_SCOPE_AGENT
#define LDS_WAIT() asm volatile("s_waitcnt lgkmcnt(0)" ::: "memory")
#define VM_WAIT() asm volatile("s_waitcnt vmcnt(0)" ::: "memory")
__device__ __forceinline__ unsigned long long rt() { return __builtin_amdgcn_s_memrealtime(); }
__device__ __forceinline__ unsigned f2bf(float f) { unsigned u = __builtin_bit_cast(unsigned, f); return (u + 0x7fffu + ((u >> 16) & 1u)) >> 16; }
__device__ __forceinline__ unsigned pk2(float lo, float hi) { return f2bf(lo) | (f2bf(hi) << 16); }

#define XB_TMO      128
#define XB_XCNT(j)  (256  + 64 * (j))
#define XB_XSUB(j)  (1280 + 64 * (j))
#define XB_XGEN(j)  (2304 + 64 * (j))
#define XB_TOP      3328
#define XB_TOPGEN   3392
#define XCD_BAR_WORDS 3456
#define XB_SPIN_CAP (1u << 18)

__device__ __forceinline__ unsigned xb_ld(unsigned* p)              { return __hip_atomic_load(p, __ATOMIC_RELAXED, __HIP_MEMORY_SCOPE_AGENT); }
__device__ __forceinline__ unsigned xb_add(unsigned* p, unsigned v) { return __hip_atomic_fetch_add(p, v, __ATOMIC_RELAXED, __HIP_MEMORY_SCOPE_AGENT); }
__device__ __forceinline__ unsigned xb_xcc_id() { return (unsigned)__builtin_amdgcn_s_getreg((3 << 11) | 20) & 0xFu; }
#define XB_SPIN(cond, bar) do { unsigned _sp = 0; while (cond) { __builtin_amdgcn_s_sleep(1); \
    if ((++_sp & 255u) == 0u) { if (xb_ld(&(bar)[XB_TMO])) break; if (_sp > XB_SPIN_CAP) { atomicAdd(&(bar)[XB_TMO], 1u); break; } } } } while (0)

struct XcdBarrier {
    unsigned* bar; unsigned x;
    volatile LAS unsigned* st;
};

__device__ __forceinline__ XcdBarrier xcd_barrier_post(unsigned* bar, volatile LAS unsigned* st) {
    XcdBarrier b; b.bar = bar; b.x = xb_xcc_id(); b.st = st;
    if (threadIdx.x == 0) (void)xb_add(&bar[XB_XCNT(b.x)], 1u);
    return b;
}
__device__ __forceinline__ void xcd_barrier_complete(unsigned* bar, unsigned x, unsigned& nloc, unsigned& nx) {
    const unsigned G = gridDim.x * gridDim.y * gridDim.z;
    unsigned sum, cnt, mine, sp = 0u;
    for (;;) {
        sum = 0u; cnt = 0u; mine = 0u;
#pragma unroll
        for (unsigned j = 0; j < 16; ++j) { const unsigned c = xb_ld(&bar[XB_XCNT(j)]); sum += c; cnt += (c > 0u) ? 1u : 0u; mine = (j == x) ? c : mine; }
        if (sum == G) break;
        __builtin_amdgcn_s_sleep(1);
        if ((++sp & 255u) == 0u) { if (xb_ld(&bar[XB_TMO])) break; if (sp > XB_SPIN_CAP) { atomicAdd(&bar[XB_TMO], 1u); break; } }
    }
    nloc = mine > 0u ? mine : 1u; nx = cnt > 0u ? cnt : 1u;
}

__device__ __forceinline__ void xcd_barrier(const XcdBarrier& b) {
    asm volatile("s_waitcnt vmcnt(0)" ::: "memory");
    __syncthreads();
    if (threadIdx.x == 0) {
        unsigned* bar = b.bar;
        __builtin_amdgcn_s_waitcnt(0);
        unsigned nloc = b.st[0], nx = b.st[1];
        if (nloc == 0u) { xcd_barrier_complete(bar, b.x, nloc, nx); b.st[0] = nloc; b.st[1] = nx; }
        const unsigned old = xb_add(&bar[XB_XSUB(b.x)], 1u);
        const unsigned gen = old / nloc;
        if (old + 1u == (gen + 1u) * nloc) {
            __builtin_amdgcn_fence(__ATOMIC_RELEASE, "agent");
            asm volatile("s_waitcnt vmcnt(0)" ::: "memory");
            const unsigned og = xb_add(&bar[XB_TOP], 1u);
            const unsigned tg = og / nx;
            if (og + 1u == (tg + 1u) * nx) xb_add(&bar[XB_TOPGEN], 1u);
            else XB_SPIN(xb_ld(&bar[XB_TOPGEN]) == tg, bar);
            __builtin_amdgcn_fence(__ATOMIC_ACQUIRE, "agent");
            xb_add(&bar[XB_XGEN(b.x)], 1u);
            asm volatile("s_waitcnt vmcnt(0)" ::: "memory");
        } else {
            XB_SPIN(xb_ld(&bar[XB_XGEN(b.x)]) == gen, bar);
            __builtin_amdgcn_fence(__ATOMIC_ACQUIRE, "agent");
            asm volatile("s_waitcnt vmcnt(0)" ::: "memory");
        }
    }
    __syncthreads();
}

constexpr int NWAVES = 8;
constexpr int DM = 2048, TP = 8192, NSMP = 1024, NTOK = 9216, DFF = 8192, PLED = 256, NG = 128, NPST = 64, NKV = 4, HD = 128, NH = 16, PASTL = 2048, NPG = 16, DECB = 128, DECT = 8;
constexpr float LN_EPS = 1e-5f, DN_ALPHA = 1.41421356237f, QSCALE = 0.12751743082459868f, LOG2E = 1.4426950408889634f;
constexpr size_t O_Y = 0, O_SRE_P = 18874368, O_SIM_P = 18882560, O_K_P = 18890752, O_V_P = 23085056, O_SRE_S = 27279360, O_SIM_S = 28327936, O_K_S = 29376512, O_V_S = 29900800, O_END = 30425088;
constexpr size_t MiB = 1u << 20;
constexpr size_t WS_CTL = 0, CTL_ZERO_BYTES = 1 * MiB;
constexpr size_t WS_WG = 2 * MiB, WS_WO5 = 10 * MiB, WS_W1_0 = 18 * MiB, WS_W2_0 = 50 * MiB, WS_WPP_0 = 82 * MiB, WS_WPG_0 = 83 * MiB, WS_WKVQ = 91 * MiB, WS_WO = 103 * MiB,
                 WS_W1_1 = 111 * MiB, WS_W2_1 = 143 * MiB, WS_WPP_1 = 175 * MiB, WS_WPG_1 = 176 * MiB;
constexpr size_t WS_PB = 184 * MiB, WS_E0 = 194 * MiB, WS_E1 = 230 * MiB, WS_G = 266 * MiB, WS_T = 302 * MiB, WS_R = 338 * MiB, WS_X = 410 * MiB, WS_XB = 482 * MiB, WS_H = 518 * MiB;
constexpr size_t WS_KB = 662 * MiB, WS_VB = 670 * MiB, WS_VT = 678 * MiB, WS_QB = 686 * MiB, WS_OB = 722 * MiB, WS_HS = 758 * MiB, WS_END = 1334 * MiB;
constexpr int CW_TMO = 0, CW_BAR = 4096;
constexpr int RING_OFF = 0, RING_BYTES = 131072, LDSCTL_OFF = RING_BYTES, MISC_OFF = LDSCTL_OFF + 320, LDS_BYTES = 147456;

__device__ __forceinline__ float wave_sum(float v) {
#pragma unroll
    for (int o = 1; o < 64; o <<= 1) v += __shfl_xor(v, o);
    return v;
}
__device__ __forceinline__ float bflo(unsigned w) { return __uint_as_float(w << 16); }
__device__ __forceinline__ float bfhi(unsigned w) { return __uint_as_float(w & 0xffff0000u); }
__device__ __forceinline__ float gelu_tanh(float v) { const float u = 0.7978845608028654f * (v + 0.044715f * v * v * v); const float th = 1.f - 2.f / (__expf(2.f * u) + 1.f); return 0.5f * v * (1.f + th); }

__device__ __forceinline__ void p0_transpose_item(const float* W, int K, int N, bf16* WT, int row_off, LAS float* scr, int item, int lane) {
    const int nblk = N / 32, kb = item / nblk, nb = item % nblk, k0 = 64 * kb, n0 = 32 * nb;
#pragma unroll 8
    for (int i = 0; i < 32; ++i) { const int kk = 2 * i + (lane >> 5); scr[kk * 33 + (lane & 31)] = W[(size_t)(k0 + kk) * N + n0 + (lane & 31)]; }
    LDS_WAIT(); asm volatile("" ::: "memory");
    const int c = lane & 7;
#pragma unroll
    for (int j = 0; j < 4; ++j) { const int n = (lane >> 3) + 8 * j; const LAS float* s = scr + (8 * c) * 33 + n;
        v4u o; o.x = pk2(s[0 * 33], s[1 * 33]); o.y = pk2(s[2 * 33], s[3 * 33]); o.z = pk2(s[4 * 33], s[5 * 33]); o.w = pk2(s[6 * 33], s[7 * 33]);
        *(GAS v4u*)(WT + (size_t)(row_off + n0 + n) * K + k0 + 8 * c) = o; }
    LDS_WAIT(); asm volatile("" ::: "memory");
}

struct Args { const void* in[34]; float* out; unsigned char* ws; int ph_lo, ph_hi, li, pad; };
typedef const __attribute__((address_space(4))) Args* KArgs;
__device__ __forceinline__ KArgs kargs() { KArgs p = (KArgs)__builtin_amdgcn_kernarg_segment_ptr(); asm volatile("" : "+s"(p)); return p; }
#define INP(T, i) ((const T*)A->in[i])
#define WSP(T, off) ((T*)(ws + (off)))

__device__ __forceinline__ void s5_setup(KArgs A, int g, int p, float& ar, float& ai, float (&bbr)[16], float (&bbi)[16]) {
    const float* lam_re = INP(float, 9); const float* lam_im = INP(float, 10); const float* log_dt = INP(float, 11);
    const float* b_re = INP(float, 12); const float* b_im = INP(float, 13);
    const double dt = exp((double)log_dt[g]); const double lr = (double)lam_re[g * 64 + p], li = (double)lam_im[g * 64 + p];
    const double mag = exp(lr * dt); double sn, cs; sincos(li * dt, &sn, &cs);
    const double abr = mag * cs, abi = mag * sn, den = lr * lr + li * li, nr = abr - 1.0;
    const double fr = (nr * lr + abi * li) / den, fi = (abi * lr - nr * li) / den;
    ar = (float)abr; ai = (float)abi;
    const float* br = b_re + ((size_t)g * 64 + p) * 16; const float* bi = b_im + ((size_t)g * 64 + p) * 16;
#pragma unroll
    for (int c = 0; c < 16; ++c) { const double x = (double)br[c], y = (double)bi[c]; bbr[c] = (float)(fr * x - fi * y); bbi[c] = (float)(fr * y + fi * x); }
}

struct Ctx { LAS unsigned char* L; int lo, hi, gw, NGW, G, bx, lane, wave, tid; };
#define IN(k) (C.lo <= (k) && (k) < C.hi)
#define BOTH(k) (IN(k) && IN((k) + 1))
#define SEAM(k) do { if (BOTH(k)) xcd_barrier(bar); } while (0)

template <bool LAST> __device__ __forceinline__ void ln_phase(const Ctx& C, const float* gam, const float* bet) {
    KArgs A = kargs(); unsigned char* ws = A->ws; const float* Rf = WSP(float, WS_R); float* Xf = LAST ? A->out + O_Y : WSP(float, WS_X); bf16* Xb = WSP(bf16, WS_XB);
    const int lane = C.lane;
    for (int row = C.gw; row < NTOK; row += C.NGW) {
        const f32x4* rr = (const f32x4*)(Rf + (size_t)row * DM) + lane; f32x4 v[8]; float s = 0.f;
#pragma unroll
        for (int j = 0; j < 8; ++j) { v[j] = rr[64 * j]; s += (v[j].x + v[j].y) + (v[j].z + v[j].w); }
        const float mean = wave_sum(s) * (1.f / DM); float s2 = 0.f;
#pragma unroll
        for (int j = 0; j < 8; ++j) { v[j] = v[j] - mean; s2 += (v[j].x * v[j].x + v[j].y * v[j].y) + (v[j].z * v[j].z + v[j].w * v[j].w); }
        const float rstd = 1.f / sqrtf(wave_sum(s2) * (1.f / DM) + LN_EPS);
#pragma unroll
        for (int j = 0; j < 8; ++j) { const f32x4 gg = ((const f32x4*)gam)[lane + 64 * j], bb = ((const f32x4*)bet)[lane + 64 * j]; const f32x4 o = v[j] * rstd * gg + bb;
            ((f32x4*)(Xf + (size_t)row * DM))[lane + 64 * j] = o;
            if (!LAST) ((unsigned long long*)(Xb + (size_t)row * DM))[lane + 64 * j] = (unsigned long long)pk2(o.x, o.y) | ((unsigned long long)pk2(o.z, o.w) << 32); }
    }
}

__device__ __forceinline__ void attn_naive_phase(const Ctx& C) {
    KArgs A = kargs(); unsigned char* ws = A->ws; float* out = A->out; const int lane = C.lane;
    const float* cache_k = INP(float, 6); const float* cache_v = INP(float, 7); const int* page_table = INP(int, 8); const float* sb_bias = INP(float, 23);
    const bf16* Kb = WSP(bf16, WS_KB); const bf16* Vb = WSP(bf16, WS_VB); const bf16* Qb = WSP(bf16, WS_QB); bf16* Ob = WSP(bf16, WS_OB);
    for (int it = C.gw; it < NTOK * NH; it += C.NGW) {
        const int row = it >> 4, h = it & 15, kvh = h >> 2;
        const float bias2 = sb_bias[h] * LOG2E;
        v4u qw[16];
        { const v4u* qp = (const v4u*)(Qb + (size_t)row * DM + h * HD);
#pragma unroll
          for (int i = 0; i < 16; ++i) qw[i] = qp[i]; }
#define QF(i) (((i) & 1) ? bfhi(qw[(i) >> 3][((i) >> 1) & 3]) : bflo(qw[(i) >> 3][((i) >> 1) & 3]))
        float o0 = 0.f, o1 = 0.f, Rc = 0.f;
        if (row < TP) {
            const int nkeys = row;
            for (int kb = (nkeys + 63) / 64 - 1; kb >= 0; --kb) {
                const int j = kb * 64 + lane; const bool valid = j < nkeys;
                const v4u* kp = (const v4u*)(Kb + (size_t)j * 512 + kvh * HD);
                float z = 0.f;
#pragma unroll
                for (int i = 0; i < 16; ++i) { const v4u w = kp[i]; z += QF(8 * i + 0) * bflo(w.x) + QF(8 * i + 1) * bfhi(w.x) + QF(8 * i + 2) * bflo(w.y) + QF(8 * i + 3) * bfhi(w.y) + QF(8 * i + 4) * bflo(w.z) + QF(8 * i + 5) * bfhi(w.z) + QF(8 * i + 6) * bflo(w.w) + QF(8 * i + 7) * bfhi(w.w); }
                z += bias2;
                const float e = valid ? __builtin_amdgcn_exp2f(z) : 0.f; const float sp = __builtin_amdgcn_logf(1.f + e);
                float s = sp;
#pragma unroll
                for (int off = 1; off < 64; off <<= 1) { const float t2 = __shfl_down(s, off); if (lane + off < 64) s += t2; }
                const float w = valid ? __builtin_amdgcn_exp2f(z - (Rc + s)) : 0.f;
                Rc += __shfl(s, 0);
                const bf16* vbase = Vb + (size_t)kb * 64 * 512 + kvh * HD + 2 * lane;
#pragma unroll 16
                for (int jj = 0; jj < 64; ++jj) { const float wj = __shfl(w, jj); const unsigned vv = *(const unsigned*)(vbase + (size_t)jj * 512); o0 += wj * bflo(vv); o1 += wj * bfhi(vv); }
            }
        } else {
            const int b = (row - TP) >> 3, t = (row - TP) & 7; const int nkeys = PASTL + t;
            for (int kb = (nkeys + 63) / 64 - 1; kb >= 0; --kb) {
                const int j = kb * 64 + lane; const bool valid = j < nkeys; const int jc = valid ? j : 0;
                size_t roff; const float* kbase; const float* vbase;
                if (jc < PASTL) { const int pg = page_table[b * NPG + (jc >> 7)]; roff = ((size_t)(pg * 128 + (jc & 127)) * NKV + kvh) * HD; kbase = cache_k; vbase = cache_v; }
                else { roff = ((size_t)(b * DECT + (jc - PASTL)) * NKV + kvh) * HD; kbase = out + O_K_S; vbase = out + O_V_S; }
                const f32x4* kp = (const f32x4*)(kbase + roff);
                float z = 0.f;
#pragma unroll
                for (int i = 0; i < 32; ++i) { const f32x4 w = kp[i]; z += QF(4 * i + 0) * w.x + QF(4 * i + 1) * w.y + QF(4 * i + 2) * w.z + QF(4 * i + 3) * w.w; }
                z += bias2;
                const float e = valid ? __builtin_amdgcn_exp2f(z) : 0.f; const float sp = __builtin_amdgcn_logf(1.f + e);
                float s = sp;
#pragma unroll
                for (int off = 1; off < 64; off <<= 1) { const float t2 = __shfl_down(s, off); if (lane + off < 64) s += t2; }
                const float w = valid ? __builtin_amdgcn_exp2f(z - (Rc + s)) : 0.f;
                Rc += __shfl(s, 0);
                const unsigned long long vaddr = (unsigned long long)(uintptr_t)(vbase + roff);
                const unsigned alo = (unsigned)vaddr, ahi = (unsigned)(vaddr >> 32);
#pragma unroll 16
                for (int jj = 0; jj < 64; ++jj) { const float wj = __shfl(w, jj); const unsigned l2 = __shfl(alo, jj), h2 = __shfl(ahi, jj);
                    const float* vr = (const float*)(uintptr_t)(((unsigned long long)h2 << 32) | l2); const float v0 = vr[2 * lane], v1 = vr[2 * lane + 1]; o0 += wj * v0; o1 += wj * v1; }
            }
        }
#undef QF
        *(unsigned*)(Ob + (size_t)row * DM + h * HD + 2 * lane) = pk2(o0, o1);
    }
}

template <int LAYER> __device__ __forceinline__ void layer_phases(const Ctx& C, const XcdBarrier& bar) {
    constexpr int PH_OUT = LAYER ? 14 : 5, PH_T = LAYER ? 15 : 6;
    LAS unsigned char* const L = C.L; const int G = C.G, bx = C.bx;
    if (LAYER == 0) {
        if (IN(4)) {
            KArgs A = kargs(); unsigned char* ws = A->ws;
            pg8::Gemm g{WSP(bf16, WS_G), WSP(bf16, WS_WG), NTOK, DM, DM}; pg8::StaticOrder S; S.init(NTOK, DM, G, bx);
            pg8::EpiGate E{WSP(bf16, WS_G), WSP(bf16, WS_T), DM};
            pg8::gemm_phase<pg8::EpiGate, pg8::StaticOrder, true, true>(L + RING_OFF, g, S, E);
            SEAM(4);
        }
    } else {
        if (IN(12)) {
            KArgs A = kargs(); unsigned char* ws = A->ws; float* out = A->out;
            pg8::Gemm g{WSP(bf16, WS_XB), WSP(bf16, WS_WKVQ), NTOK, 3072, DM}; pg8::StaticOrder S; S.init(NTOK, 3072, G, bx);
            pg8::EpiKVQ E{out + O_K_P, out + O_K_S, out + O_V_P, out + O_V_S, WSP(bf16, WS_KB), WSP(bf16, WS_VB), WSP(bf16, WS_VT), WSP(bf16, WS_QB), QSCALE};
            pg8::gemm_phase<pg8::EpiKVQ, pg8::StaticOrder, true, true>(L + RING_OFF, g, S, E);
            SEAM(12);
        }
        if (IN(13)) { attn_naive_phase(C); SEAM(13); }
    }
    if (IN(PH_OUT)) {
        KArgs A = kargs(); unsigned char* ws = A->ws;
        pg8::Gemm g{LAYER ? WSP(bf16, WS_OB) : WSP(bf16, WS_T), LAYER ? WSP(bf16, WS_WO) : WSP(bf16, WS_WO5), NTOK, DM, DM}; pg8::StaticOrder S; S.init(NTOK, DM, G, bx);
        const float* xlo = LAYER ? WSP(float, WS_X) : INP(float, 0); const float* xhi = LAYER ? WSP(float, WS_X) : INP(float, 1) - (size_t)TP * DM;
        pg8::EpiRes E{xlo, xhi, WSP(float, WS_R), DM, DN_ALPHA};
        pg8::gemm_phase<pg8::EpiRes, pg8::StaticOrder, true, true>(L + RING_OFF, g, S, E);
        SEAM(PH_OUT);
    }
    if (IN(PH_T + 0)) { KArgs A = kargs(); ln_phase<false>(C, INP(float, 24) + LAYER * DM, INP(float, 25) + LAYER * DM); SEAM(PH_T + 0); }
    if (IN(PH_T + 1)) {
        KArgs A = kargs(); unsigned char* ws = A->ws;
        pg8::Gemm g{WSP(bf16, WS_XB), WSP(bf16, LAYER ? WS_W1_1 : WS_W1_0), NTOK, DFF, DM}; pg8::StaticOrder S; S.init(NTOK, DFF, G, bx);
        pg8::EpiAct<1> E{WSP(bf16, WS_H), DFF};
        pg8::gemm_phase<pg8::EpiAct<1>, pg8::StaticOrder, true, true>(L + RING_OFF, g, S, E);
        SEAM(PH_T + 1);
    }
    if (IN(PH_T + 2)) {
        KArgs A = kargs(); unsigned char* ws = A->ws;
        pg8::Gemm g{WSP(bf16, WS_H), WSP(bf16, LAYER ? WS_W2_1 : WS_W2_0), NTOK, DM, DFF}; pg8::StaticOrder S; S.init(NTOK, DM, G, bx);
        pg8::EpiRes E{WSP(float, WS_X), WSP(float, WS_X), WSP(float, WS_R), DM, DN_ALPHA};
        pg8::gemm_phase<pg8::EpiRes, pg8::StaticOrder, true, true>(L + RING_OFF, g, S, E);
        SEAM(PH_T + 2);
    }
    if (IN(PH_T + 3)) { KArgs A = kargs(); ln_phase<false>(C, INP(float, 28) + LAYER * DM, INP(float, 29) + LAYER * DM); SEAM(PH_T + 3); }
    if (IN(PH_T + 4)) {
        KArgs A = kargs(); unsigned char* ws = A->ws;
        pg8::Gemm g{WSP(bf16, WS_XB), WSP(bf16, LAYER ? WS_WPG_1 : WS_WPG_0), NTOK, DM, DM}; pg8::StaticOrder S; S.init(NTOK, DM, G, bx);
        pg8::EpiPle E{WSP(float, WS_X), WSP(bf16, LAYER ? WS_E1 : WS_E0), WSP(float, WS_R), DM, DN_ALPHA};
        pg8::gemm_phase<pg8::EpiPle, pg8::StaticOrder, true, true>(L + RING_OFF, g, S, E);
        SEAM(PH_T + 4);
    }
    if (IN(PH_T + 5)) { KArgs A = kargs(); ln_phase<LAYER == 1>(C, INP(float, 32) + LAYER * DM, INP(float, 33) + LAYER * DM); SEAM(PH_T + 5); }
}

__global__ void __launch_bounds__(NWAVES * 64, 2) skel_fwd(Args args) {
    extern __shared__ __attribute__((aligned(16))) unsigned char lds[];
    Ctx C; C.L = (LAS unsigned char*)lds;
    LAS unsigned char* const L = C.L;
    volatile LAS unsigned* const MISC = (volatile LAS unsigned*)(L + MISC_OFF);
    C.tid = threadIdx.x; C.lane = C.tid & 63; C.wave = __builtin_amdgcn_readfirstlane(C.tid >> 6);
    C.G = gridDim.x; C.bx = blockIdx.x; C.lo = args.ph_lo; C.hi = args.ph_hi;
    C.gw = C.wave * C.G + C.bx; C.NGW = C.G * NWAVES;
    const int tid = C.tid, lane = C.lane, wave = C.wave, G = C.G, bx = C.bx, gw = C.gw, NGW = C.NGW;
    for (int u = tid; u < (LDS_BYTES - LDSCTL_OFF) / 4; u += NWAVES * 64) ((LAS unsigned*)(L + LDSCTL_OFF))[u] = 0u;
    __syncthreads();
    const bool use_bar = (C.hi - C.lo) > 1;
    XcdBarrier bar; bar.bar = (unsigned*)(args.ws + WS_CTL) + CW_BAR + args.li * XCD_BAR_WORDS; bar.x = 0; bar.st = nullptr;
    if (use_bar) bar = xcd_barrier_post((unsigned*)(args.ws + WS_CTL) + CW_BAR + args.li * XCD_BAR_WORDS, MISC + 8);

    if (IN(0)) {
        KArgs A = kargs(); unsigned char* ws = A->ws;
        LAS float* scr = (LAS float*)(L + RING_OFF + wave * 16384);
        constexpr int I_SQ = (DM / 64) * (DM / 32), I_W1 = (DM / 64) * (DFF / 32), I_W2 = (DFF / 64) * (DM / 32), I_PP = (PLED / 64) * (DM / 32), I_KV = (DM / 64) * (512 / 32);
        constexpr int PER_L = I_W1 + I_W2 + I_PP + I_SQ;
        constexpr int NITEMS = 4 * I_SQ + 2 * I_KV + 2 * PER_L;
        for (int it = gw; it < NITEMS; it += NGW) {
            int r = it;
            if (r < I_SQ) { p0_transpose_item(INP(float, 17), DM, DM, WSP(bf16, WS_WG), 0, scr, r, lane); continue; } r -= I_SQ;
            if (r < I_SQ) { p0_transpose_item(INP(float, 18), DM, DM, WSP(bf16, WS_WO5), 0, scr, r, lane); continue; } r -= I_SQ;
            if (r < I_KV) { p0_transpose_item(INP(float, 19), DM, 512, WSP(bf16, WS_WKVQ), 0, scr, r, lane); continue; } r -= I_KV;
            if (r < I_KV) { p0_transpose_item(INP(float, 20), DM, 512, WSP(bf16, WS_WKVQ), 512, scr, r, lane); continue; } r -= I_KV;
            if (r < I_SQ) { p0_transpose_item(INP(float, 21), DM, DM, WSP(bf16, WS_WKVQ), 1024, scr, r, lane); continue; } r -= I_SQ;
            if (r < I_SQ) { p0_transpose_item(INP(float, 22), DM, DM, WSP(bf16, WS_WO), 0, scr, r, lane); continue; } r -= I_SQ;
            const int l = r / PER_L; r -= l * PER_L;
            if (r < I_W1) { p0_transpose_item(INP(float, 26) + (size_t)l * DM * DFF, DM, DFF, WSP(bf16, l ? WS_W1_1 : WS_W1_0), 0, scr, r, lane); continue; } r -= I_W1;
            if (r < I_W2) { p0_transpose_item(INP(float, 27) + (size_t)l * DM * DFF, DFF, DM, WSP(bf16, l ? WS_W2_1 : WS_W2_0), 0, scr, r, lane); continue; } r -= I_W2;
            if (r < I_PP) { p0_transpose_item(INP(float, 30) + (size_t)l * PLED * DM, PLED, DM, WSP(bf16, l ? WS_WPP_1 : WS_WPP_0), 0, scr, r, lane); continue; } r -= I_PP;
            p0_transpose_item(INP(float, 31) + (size_t)l * DM * DM, DM, DM, WSP(bf16, l ? WS_WPG_1 : WS_WPG_0), 0, scr, r, lane);
        }
        const float* p_prompt = INP(float, 2); const float* p_sample = INP(float, 3); bf16* Pb = WSP(bf16, WS_PB);
        for (int i = bx * 512 + tid; i < 2 * NTOK * PLED / 4; i += G * 512) {
            const int l = i / (NTOK * PLED / 4), rem = i % (NTOK * PLED / 4), row = rem / (PLED / 4), c4 = rem % (PLED / 4);
            const float* src = row < TP ? p_prompt + ((size_t)l * TP + row) * PLED + 4 * c4 : p_sample + ((size_t)l * NSMP + (row - TP)) * PLED + 4 * c4;
            const f32x4 v = *(const f32x4*)src; unsigned long long o = (unsigned long long)pk2(v.x, v.y) | ((unsigned long long)pk2(v.z, v.w) << 32);
            *(unsigned long long*)(Pb + ((size_t)l * NTOK + row) * PLED + 4 * c4) = o;
        }
        SEAM(0);
    }

    if (IN(1)) {
        KArgs A = kargs(); unsigned char* ws = A->ws; float* out = A->out; float* Hs = WSP(float, WS_HS);
        const float* x_prompt = INP(float, 0); const float* x_sample = INP(float, 1); const float* st_re = INP(float, 4); const float* st_im = INP(float, 5);
        for (int it = gw; it < NG + NG * DECB; it += NGW) {
            const bool isp = it < NG; const int g = isp ? it : (it - NG) & 127; const int b = isp ? 0 : (it - NG) >> 7;
            float ar, ai, bbr[16], bbi[16]; s5_setup(A, g, lane, ar, ai, bbr, bbi);
            float hr = 0.f, hi_ = 0.f; int row0, nt; const float* xs;
            if (isp) { row0 = 0; nt = TP; xs = x_prompt + g * 16; }
            else { row0 = TP + b * DECT; nt = DECT; xs = x_sample + (size_t)b * DECT * DM + g * 16; hr = st_re[((size_t)b * NG + g) * 64 + lane]; hi_ = st_im[((size_t)b * NG + g) * 64 + lane]; }
#pragma unroll 4
            for (int t = 0; t < nt; ++t) {
                const f32x4* up = (const f32x4*)(xs + (size_t)t * DM); const f32x4 u0 = up[0], u1 = up[1], u2 = up[2], u3 = up[3];
                const float uu[16] = {u0.x, u0.y, u0.z, u0.w, u1.x, u1.y, u1.z, u1.w, u2.x, u2.y, u2.z, u2.w, u3.x, u3.y, u3.z, u3.w};
                float br = 0.f, bi = 0.f;
#pragma unroll
                for (int c = 0; c < 16; ++c) { br += bbr[c] * uu[c]; bi += bbi[c] * uu[c]; }
                const float nr = ar * hr - ai * hi_ + br, ni = ar * hi_ + ai * hr + bi; hr = nr; hi_ = ni;
                float* hp = Hs + ((size_t)(row0 + t) * NG + g) * 128; hp[lane] = hr; hp[64 + lane] = hi_;
            }
            if (isp) { out[O_SRE_P + g * 64 + lane] = hr; out[O_SIM_P + g * 64 + lane] = hi_; }
            else { out[O_SRE_S + ((size_t)b * NG + g) * 64 + lane] = hr; out[O_SIM_S + ((size_t)b * NG + g) * 64 + lane] = hi_; }
        }
        SEAM(1);
    }

    if (IN(2)) {
        KArgs A = kargs(); unsigned char* ws = A->ws; const float* Hs = WSP(float, WS_HS); bf16* Gb = WSP(bf16, WS_G);
        const float* x_prompt = INP(float, 0); const float* x_sample = INP(float, 1); const float* c_re = INP(float, 14); const float* c_im = INP(float, 15); const float* s5_d = INP(float, 16);
        for (int it = gw; it < NTOK * NG; it += NGW) {
            const int row = it >> 7, g = it & 127;
            const float* hp = Hs + ((size_t)row * NG + g) * 128; const float hr = hp[lane], hi_ = hp[64 + lane];
            float yv = 0.f;
#pragma unroll
            for (int c = 0; c < 16; ++c) { float v = c_re[((size_t)g * 16 + c) * 64 + lane] * hr - c_im[((size_t)g * 16 + c) * 64 + lane] * hi_; v = wave_sum(v); if (lane == c) yv = v; }
            if (lane < 16) { const int col = g * 16 + lane; const float xv = row < TP ? x_prompt[(size_t)row * DM + col] : x_sample[(size_t)(row - TP) * DM + col];
                const float v = yv + s5_d[col] * xv; Gb[(size_t)row * DM + col] = (bf16)f2bf(gelu_tanh(v)); }
        }
        SEAM(2);
    }

    if (IN(3)) {
        { KArgs A = kargs(); unsigned char* ws = A->ws;
          pg8::Gemm g{WSP(bf16, WS_PB), WSP(bf16, WS_WPP_0), NTOK, DM, PLED}; pg8::StaticOrder S; S.init(NTOK, DM, G, bx);
          pg8::EpiAct<0> E{WSP(bf16, WS_E0), DM};
          pg8::gemm_phase<pg8::EpiAct<0>, pg8::StaticOrder, false, false>(L + RING_OFF, g, S, E); }
        __syncthreads();
        { KArgs A = kargs(); unsigned char* ws = A->ws;
          pg8::Gemm g{WSP(bf16, WS_PB) + (size_t)NTOK * PLED, WSP(bf16, WS_WPP_1), NTOK, DM, PLED}; pg8::StaticOrder S; S.init(NTOK, DM, G, bx);
          pg8::EpiAct<0> E{WSP(bf16, WS_E1), DM};
          pg8::gemm_phase<pg8::EpiAct<0>, pg8::StaticOrder, false, false>(L + RING_OFF, g, S, E); }
        SEAM(3);
    }

    layer_phases<0>(C, bar);
    layer_phases<1>(C, bar);
}
#undef IN
#undef BOTH
#undef SEAM

constexpr int N_PHASES = 21;
#ifndef MK_N_LAUNCHES
#define MK_N_LAUNCHES N_PHASES
#endif
extern "C" void kernel_launch(void* const* d_in, const int* in_sizes, int n_in, void* d_out, int out_size, void* d_ws, size_t ws_size, hipStream_t stream) {
    static int grid = 0;
    if (grid == 0) {
        if (n_in != 34 || out_size != (int)O_END || ws_size < WS_END) { fprintf(stderr, "kernel_launch: unexpected shapes: n_in %d out %d ws %zu\n", n_in, out_size, ws_size); grid = -1; return; }
        int dev = 0, cus = 0, per_cu = 0;
        if (hipGetDevice(&dev) != hipSuccess || hipDeviceGetAttribute(&cus, hipDeviceAttributeMultiprocessorCount, dev) != hipSuccess) { grid = -1; return; }
        if (hipFuncSetAttribute((const void*)skel_fwd, hipFuncAttributeMaxDynamicSharedMemorySize, LDS_BYTES) != hipSuccess) { fprintf(stderr, "kernel_launch: hipFuncSetAttribute failed\n"); grid = -1; return; }
        if (hipOccupancyMaxActiveBlocksPerMultiprocessor(&per_cu, (const void*)skel_fwd, NWAVES * 64, LDS_BYTES) != hipSuccess || per_cu < 1) fprintf(stderr, "kernel_launch: occupancy query reports %d\n", per_cu);
        (void)hipGetLastError();
        grid = cus;
    }
    if (grid < 0) return;
    (void)hipMemsetAsync((char*)d_ws + WS_CTL, 0, CTL_ZERO_BYTES, stream);
    Args a{};
    for (int i = 0; i < 34; ++i) a.in[i] = d_in[i];
    a.out = (float*)d_out; a.ws = (unsigned char*)d_ws;
    constexpr int NL = MK_N_LAUNCHES;
    for (int li = 0; li < NL; ++li) {
        a.ph_lo = (NL == N_PHASES) ? li : (li * N_PHASES) / NL; a.ph_hi = (NL == N_PHASES) ? li + 1 : ((li + 1) * N_PHASES) / NL; a.li = li; a.pad = 0;
        hipLaunchKernelGGL(skel_fwd, dim3(grid), dim3(NWAVES * 64), LDS_BYTES, stream, a);
    }
}
```

```cpp
#include <hip/hip_runtime.h>
#include <cstdio>
#include <cstdint>
namespace pg8 {
#define PG8_LAS __attribute__((address_space(3)))
typedef unsigned short bf16_t;
typedef short bf16x8 __attribute__((ext_vector_type(8)));
typedef float f32x4 __attribute__((ext_vector_type(4)));
typedef unsigned u32x4 __attribute__((ext_vector_type(4)));
constexpr int BM = 256, BK = 64, HALF = 128, HTB = HALF * BK * 2  , STAGE_BYTES = 8 * HTB, NXCD = 8, WGM = 8;

__host__ __device__ __forceinline__ int lds_byte(int r, int c) { const int st = (r >> 4) * 2 + (c >> 5), rr = r & 15, cc = c & 31, ob = rr * 64 + cc * 2; return st * 1024 + (ob ^ (((ob >> 9) & 1) << 5)); }
__host__ __device__ __forceinline__ void stage_rc(int b, int& R, int& C) { const int st = b / 1024, sb = b % 1024, swz = sb ^ (((sb >> 9) & 1) << 5); R = (st >> 1) * 16 + swz / 64; C = (st & 1) * 32 + (swz % 64) / 2; }
__host__ __device__ __forceinline__ int perm32(int rho) { const int n = rho >> 4, i = rho & 15; return 8 * (i >> 2) + 4 * n + (i & 3); }

struct Unit { int pm, pn; };
struct Gemm { const bf16_t* A; const bf16_t* Bt; int M, N, K; };

struct StaticOrder {
    int nM, nN, nwg, G, c;
    __host__ __device__ void init(int M, int N, int G_, int c_) { nM = M / BM; nN = N / BM; nwg = nM * nN; G = G_; c = c_; }
    __host__ __device__ bool next(int i, Unit& u) const {
        const long L = (long)i * G + c; if (L >= nwg) return false;
        int wgid = (int)L; { const int q = nwg / NXCD, r = nwg % NXCD, xcd = wgid % NXCD, off = wgid / NXCD; wgid = (xcd < r ? xcd * (q + 1) : r * (q + 1) + (xcd - r) * q) + off; }
        const int nig = WGM * nN, gid = wgid / nig, fm = gid * WGM, gsz = (nM - fm) < WGM ? (nM - fm) : WGM;
        u.pm = fm + ((wgid % nig) % gsz); u.pn = (wgid % nig) / gsz; return true;
    }
    __device__ __forceinline__ void a_ready(const Unit&) const {}
    __device__ __forceinline__ void done(const Unit&) const {}
};

__device__ __forceinline__ unsigned cvt_pk_bf16(float lo, float hi) { unsigned r; asm volatile("v_cvt_pk_bf16_f32 %0, %1, %2" : "=v"(r) : "v"(lo), "v"(hi)); return r; }
typedef float f32x2 __attribute__((ext_vector_type(2)));
typedef unsigned u32x2 __attribute__((ext_vector_type(2)));
typedef float f32x2e __attribute__((ext_vector_type(2)));
constexpr float EPI_INV_D = 1.0f / 2048.0f, EPI_EPS = 1e-5f;
__device__ __forceinline__ float bf_lo(unsigned w) { return __uint_as_float(w << 16); }
__device__ __forceinline__ float bf_hi(unsigned w) { return __uint_as_float(w & 0xffff0000u); }
__device__ __forceinline__ float sigm(float x) { return __builtin_amdgcn_rcpf(1.f + __expf(-x)); }
__device__ __forceinline__ u32x2 pack4(f32x4 v) { u32x2 w; w.x = cvt_pk_bf16(v[0], v[1]); w.y = cvt_pk_bf16(v[2], v[3]); return w; }
__host__ __device__ __forceinline__ int perm16(int k) { return (k & 3) | (((k >> 3) & 1) << 2) | (((k >> 2) & 1) << 3); }
__device__ __forceinline__ f32x2e stat_get(const float* st, int row) { const f32x2e v = *(const f32x2e*)(st + 2 * (size_t)row); const float mu = v.x * EPI_INV_D; const float var = v.y * EPI_INV_D - mu * mu; return (f32x2e){mu, __builtin_amdgcn_rsqf(var + EPI_EPS)}; }
__device__ __forceinline__ void stat_add(float* st, int row, float s, float q, int fq) { s += __shfl_xor(s, 16); s += __shfl_xor(s, 32); q += __shfl_xor(q, 16); q += __shfl_xor(q, 32); if (fq < 2) atomicAdd(st + 2 * (size_t)row + fq, fq ? q : s); }

struct EpiGate { static constexpr bool PERM = true, AFTER_DRAIN = false; const bf16_t* Gm; bf16_t* O; int ldc;
    __device__ __forceinline__ void operator()(const f32x4 (&acc)[2][2][4][2], const Unit& u, int wr, int wc, int fr, int fq) const {
        const int row0 = u.pm * BM + wr * 64 + fr, col0 = u.pn * BM + wc * 32 + 8 * fq;
#pragma unroll
        for (int ai = 0; ai < 2; ++ai)
#pragma unroll
            for (int m = 0; m < 4; ++m) { const size_t off = (size_t)(row0 + ai * HALF + m * 16) * ldc + col0;
#pragma unroll
                for (int bj = 0; bj < 2; ++bj) { const u32x4 g = *(const u32x4*)(Gm + off + bj * HALF); const f32x4 v0 = acc[ai][bj][m][0], v1 = acc[ai][bj][m][1];
                    u32x4 w;
                    w.x = cvt_pk_bf16(bf_lo(g.x) * sigm(v0[0]), bf_hi(g.x) * sigm(v0[1]));
                    w.y = cvt_pk_bf16(bf_lo(g.y) * sigm(v0[2]), bf_hi(g.y) * sigm(v0[3]));
                    w.z = cvt_pk_bf16(bf_lo(g.z) * sigm(v1[0]), bf_hi(g.z) * sigm(v1[1]));
                    w.w = cvt_pk_bf16(bf_lo(g.w) * sigm(v1[2]), bf_hi(g.w) * sigm(v1[3]));
                    *(u32x4*)(O + off + bj * HALF) = w; } }
    }
};
template <int ACT> struct EpiAct { static constexpr bool PERM = true, AFTER_DRAIN = false; bf16_t* O; int ldc; const float* st; const float* c1; const float* c2;
    __device__ __forceinline__ void operator()(const f32x4 (&acc)[2][2][4][2], const Unit& u, int wr, int wc, int fr, int fq) const {
        const int row0 = u.pm * BM + wr * 64 + fr, col0 = u.pn * BM + wc * 32 + 8 * fq;
        f32x2e ms[8];
#pragma unroll
        for (int i = 0; i < 8; ++i) ms[i] = (ACT == 1) ? stat_get(st, row0 + (i >> 2) * HALF + (i & 3) * 16) : (f32x2e){0.f, 1.f};
#pragma unroll
        for (int bj = 0; bj < 2; ++bj) { const int c = col0 + bj * HALF; f32x4 a0 = {0.f, 0.f, 0.f, 0.f}, a1 = a0, b0 = a0, b1 = a0;
            if (ACT == 1) { a0 = *(const f32x4*)(c1 + c); a1 = *(const f32x4*)(c1 + c + 4); b0 = *(const f32x4*)(c2 + c); b1 = *(const f32x4*)(c2 + c + 4); }
#pragma unroll
            for (int i = 0; i < 8; ++i) { const int ai = i >> 2, m = i & 3; const size_t off = (size_t)(row0 + ai * HALF + m * 16) * ldc + c; f32x4 v0 = acc[ai][bj][m][0], v1 = acc[ai][bj][m][1];
                if (ACT == 1) { v0 = (v0 - a0 * ms[i].x) * ms[i].y + b0; v1 = (v1 - a1 * ms[i].x) * ms[i].y + b1;
#pragma unroll
                    for (int k = 0; k < 4; ++k) { const float a = fmaxf(v0[k], 0.f), b = fmaxf(v1[k], 0.f); v0[k] = a * a; v1[k] = b * b; } }
                u32x4 w; w.x = cvt_pk_bf16(v0[0], v0[1]); w.y = cvt_pk_bf16(v0[2], v0[3]); w.z = cvt_pk_bf16(v1[0], v1[1]); w.w = cvt_pk_bf16(v1[2], v1[3]);
                *(u32x4*)(O + off) = w; } }
    }
};
__device__ __forceinline__ void unpack8(u32x4 w, f32x4& lo, f32x4& hi) { lo = (f32x4){bf_lo(w.x), bf_hi(w.x), bf_lo(w.y), bf_hi(w.y)}; hi = (f32x4){bf_lo(w.z), bf_hi(w.z), bf_lo(w.w), bf_hi(w.w)}; }
__device__ __forceinline__ u32x4 pack8f(f32x4 lo, f32x4 hi) { u32x4 w; w.x = cvt_pk_bf16(lo[0], lo[1]); w.y = cvt_pk_bf16(lo[2], lo[3]); w.z = cvt_pk_bf16(hi[0], hi[1]); w.w = cvt_pk_bf16(hi[2], hi[3]); return w; }
__device__ __forceinline__ float sum4(f32x4 v) { return (v[0] + v[1]) + (v[2] + v[3]); }
__device__ __forceinline__ float sq4(f32x4 v) { return (v[0] * v[0] + v[1] * v[1]) + (v[2] * v[2] + v[3] * v[3]); }
struct EpiRes { static constexpr bool PERM = true, AFTER_DRAIN = false; const float* xlo; const float* xhi; const bf16_t* xb; const float* stp; const float* gp; const float* bp; float* R; bf16_t* Rb; float* stn; int ldc; float alpha;
    __device__ __forceinline__ void operator()(const f32x4 (&acc)[2][2][4][2], const Unit& u, int wr, int wc, int fr, int fq) const {
        const float* X = (u.pm < 32) ? xlo : xhi; const int col0 = u.pn * BM + wc * 32 + 8 * fq;
#pragma unroll
        for (int ai = 0; ai < 2; ++ai)
#pragma unroll
            for (int m = 0; m < 4; ++m) { const int row = u.pm * BM + ai * HALF + wr * 64 + m * 16 + fr; const size_t off = (size_t)row * ldc + col0;
                f32x2e ms = {0.f, 1.f}; if (stp) ms = stat_get(stp, row);
                float s = 0.f, q = 0.f;
#pragma unroll
                for (int bj = 0; bj < 2; ++bj) { const int co = bj * HALF; f32x4 x0, x1;
                    if (stp) { unpack8(*(const u32x4*)(xb + off + co), x0, x1);
                        const f32x4 g0 = *(const f32x4*)(gp + col0 + co), g1 = *(const f32x4*)(gp + col0 + co + 4), b0 = *(const f32x4*)(bp + col0 + co), b1 = *(const f32x4*)(bp + col0 + co + 4);
                        x0 = (x0 - ms.x) * ms.y * g0 + b0; x1 = (x1 - ms.x) * ms.y * g1 + b1; }
                    else { x0 = *(const f32x4*)(X + off + co); x1 = *(const f32x4*)(X + off + co + 4); }
                    const f32x4 r0 = x0 * alpha + acc[ai][bj][m][0], r1 = x1 * alpha + acc[ai][bj][m][1];
                    if (R) { *(f32x4*)(R + off + co) = r0; *(f32x4*)(R + off + co + 4) = r1; }
                    *(u32x4*)(Rb + off + co) = pack8f(r0, r1);
                    s += sum4(r0) + sum4(r1); q += sq4(r0) + sq4(r1); }
                stat_add(stn, row, s, q, fq); }
    }
};
struct EpiPle { static constexpr bool PERM = true, AFTER_DRAIN = false; const bf16_t* X; const bf16_t* E; const float* stp; const float* gp; const float* bp; const float* c1; const float* c2; float* R; bf16_t* Rb; float* stn; int ldc; float alpha;
    __device__ __forceinline__ void operator()(const f32x4 (&acc)[2][2][4][2], const Unit& u, int wr, int wc, int fr, int fq) const {
        const int col0 = u.pn * BM + wc * 32 + 8 * fq;
#pragma unroll
        for (int ai = 0; ai < 2; ++ai)
#pragma unroll
            for (int m = 0; m < 4; ++m) { const int row = u.pm * BM + ai * HALF + wr * 64 + m * 16 + fr; const size_t off = (size_t)row * ldc + col0;
                const f32x2e ms = stat_get(stp, row);
                float s = 0.f, q = 0.f;
#pragma unroll
                for (int bj = 0; bj < 2; ++bj) { const int co = bj * HALF; const int cc = col0 + co; f32x4 x0, x1, e0, e1;
                    unpack8(*(const u32x4*)(X + off + co), x0, x1); unpack8(*(const u32x4*)(E + off + co), e0, e1);
                    { const f32x4 g0 = *(const f32x4*)(gp + cc), g1 = *(const f32x4*)(gp + cc + 4), b0 = *(const f32x4*)(bp + cc), b1 = *(const f32x4*)(bp + cc + 4); x0 = (x0 - ms.x) * ms.y * g0 + b0; x1 = (x1 - ms.x) * ms.y * g1 + b1; }
                    f32x4 v0, v1;
                    { const f32x4 a0 = *(const f32x4*)(c1 + cc), a1 = *(const f32x4*)(c1 + cc + 4), d0 = *(const f32x4*)(c2 + cc), d1 = *(const f32x4*)(c2 + cc + 4); v0 = (acc[ai][bj][m][0] - a0 * ms.x) * ms.y + d0; v1 = (acc[ai][bj][m][1] - a1 * ms.x) * ms.y + d1; }
                    f32x4 r0, r1;
#pragma unroll
                    for (int k = 0; k < 4; ++k) { r0[k] = x0[k] * alpha + e0[k] * sigm(v0[k]); r1[k] = x1[k] * alpha + e1[k] * sigm(v1[k]); }
                    if (R) { *(f32x4*)(R + off + co) = r0; *(f32x4*)(R + off + co + 4) = r1; }
                    if (Rb) *(u32x4*)(Rb + off + co) = pack8f(r0, r1);
                    s += sum4(r0) + sum4(r1); q += sq4(r0) + sq4(r1); }
                stat_add(stn, row, s, q, fq); }
    }
};
struct EpiKVQ { static constexpr bool PERM = false, AFTER_DRAIN = false; float* kp; float* vp; bf16_t* Kb; bf16_t* Vt; bf16_t* Qb; const float* st; const float* c1; const float* c2; float qscale;
    __device__ __forceinline__ void operator()(const f32x4 (&acc)[2][2][4][2], const Unit& u, int wr, int wc, int fr, int fq) const {
        const int colt = u.pn * BM + wc * 32 + 4 * fq;
#pragma unroll
        for (int ai = 0; ai < 2; ++ai)
#pragma unroll
            for (int m = 0; m < 4; ++m) { const int r = u.pm * BM + ai * HALF + wr * 64 + m * 16 + fr; const f32x2e ms = stat_get(st, r);
#pragma unroll
                for (int bj = 0; bj < 2; ++bj)
#pragma unroll
                    for (int n = 0; n < 2; ++n) { const int c = colt + bj * HALF + n * 16; const f32x4 a4 = *(const f32x4*)(c1 + c), d4 = *(const f32x4*)(c2 + c);
                        const f32x4 v = (acc[ai][bj][m][n] - a4 * ms.x) * ms.y + d4;
                        if (u.pn < 2) { *(f32x4*)(kp + (size_t)r * 512 + c) = v; *(u32x2*)(Kb + (size_t)r * 512 + c) = pack4(v); }
                        else if (u.pn < 4) { const int cc = c - 512; *(f32x4*)(vp + (size_t)r * 512 + cc) = v;
                            const u32x2 pk = pack4(v); const int pr = (r & ~15) | perm16(r & 15);
                            Vt[(size_t)(cc + 0) * 8192 + pr] = (bf16_t)(pk.x & 0xffffu); Vt[(size_t)(cc + 1) * 8192 + pr] = (bf16_t)(pk.x >> 16);
                            Vt[(size_t)(cc + 2) * 8192 + pr] = (bf16_t)(pk.y & 0xffffu); Vt[(size_t)(cc + 3) * 8192 + pr] = (bf16_t)(pk.y >> 16); }
                        else { const int qc = c - 1024; *(u32x2*)(Qb + (size_t)r * 2048 + qc) = pack4(v * qscale); } } }
    }
};
struct EpiKVQS { static constexpr bool PERM = false, AFTER_DRAIN = false; float* ks; float* vs; bf16_t* Qb; const float* st; const float* c1; const float* c2; float qscale;
    __device__ __forceinline__ void operator()(const f32x4 (&acc)[2][2][4][2], const Unit& u, int wr, int wc, int fr, int fq) const {
        const int colt = u.pn * BM + wc * 32 + 4 * fq;
#pragma unroll
        for (int ai = 0; ai < 2; ++ai)
#pragma unroll
            for (int m = 0; m < 4; ++m) { const int r = u.pm * BM + ai * HALF + wr * 64 + m * 16 + fr; const f32x2e ms = stat_get(st, r);
#pragma unroll
                for (int bj = 0; bj < 2; ++bj)
#pragma unroll
                    for (int n = 0; n < 2; ++n) { const int c = colt + bj * HALF + n * 16; const f32x4 a4 = *(const f32x4*)(c1 + c), d4 = *(const f32x4*)(c2 + c);
                        const f32x4 v = (acc[ai][bj][m][n] - a4 * ms.x) * ms.y + d4;
                        if (u.pn < 2) *(f32x4*)(ks + (size_t)(r - 8192) * 512 + c) = v;
                        else if (u.pn < 4) *(f32x4*)(vs + (size_t)(r - 8192) * 512 + (c - 512)) = v;
                        else *(u32x2*)(Qb + (size_t)r * 2048 + (c - 1024)) = pack4(v * qscale); } }
    }
};


template <class Epi, class Sched, bool ALIGN_EPI = false, bool SP2 = false>
__device__ __forceinline__ void gemm_phase(PG8_LAS unsigned char* lds, const Gemm g, const Sched& S, const Epi& E) {
    const int tid = threadIdx.x, wid = __builtin_amdgcn_readfirstlane(tid >> 6), lane = tid & 63, wr = wid >> 2, wc = wid & 3, fr = lane & 15, fq = lane >> 4;
    const int K = g.K, nt = K / BK;
    unsigned voffA[2], voffB[2];
#pragma unroll
    for (int i = 0; i < 2; ++i) { int R, C; stage_rc(tid * 16 + i * 8192, R, C); const int Rb = Epi::PERM ? ((R & ~31) + perm32(R & 31)) : R;
        voffA[i] = (unsigned)(R * K + C) * 2u; voffB[i] = (unsigned)(Rb * K + C) * 2u; }
    const size_t kstep = (size_t)(BK * 2);
    const size_t hstep = (size_t)HALF * K * 2;
    const size_t tstep = 2 * hstep;
    const unsigned ldsw = (unsigned)wid * 1024u;
    const int aoff = lds_byte(wr * 64 + fr, fq * 8), boff = lds_byte(wc * 32 + fr, fq * 8);
#define PG8_SA(b, h) (((b) * 2 + (h)) * HTB)
#define PG8_SB(b, h) ((4 + (b) * 2 + (h)) * HTB)
#define PG8_STAGE(bufoff, gbase, voff) do { _Pragma("unroll") for (int _i = 0; _i < 2; ++_i) \
        __builtin_amdgcn_global_load_lds((const unsigned*)((const char*)(gbase) + (voff)[_i]), (PG8_LAS unsigned*)(lds + (bufoff) + ldsw + _i * 8192), 16, 0, 0); } while (0)
#define PG8_LDA(dst, b, h) do { _Pragma("unroll") for (int m = 0; m < 4; ++m) _Pragma("unroll") for (int k = 0; k < 2; ++k) dst[m][k] = *(const PG8_LAS bf16x8*)(lds + PG8_SA(b, h) + aoff + m * 2048 + k * 1024); } while (0)
#define PG8_LDB(dst, b, h) do { _Pragma("unroll") for (int n = 0; n < 2; ++n) _Pragma("unroll") for (int k = 0; k < 2; ++k) dst[n][k] = *(const PG8_LAS bf16x8*)(lds + PG8_SB(b, h) + boff + n * 2048 + k * 1024); } while (0)
#define PG8_MMA(ai, bj, At, Bt) do { __builtin_amdgcn_s_setprio(1); _Pragma("unroll") for (int m = 0; m < 4; ++m) _Pragma("unroll") for (int n = 0; n < 2; ++n) _Pragma("unroll") for (int k = 0; k < 2; ++k) \
        acc[ai][bj][m][n] = __builtin_amdgcn_mfma_f32_16x16x32_bf16(Bt[n][k], At[m][k], acc[ai][bj][m][n], 0, 0, 0); __builtin_amdgcn_s_setprio(0); } while (0)
#define PG8_WAIT_V(n) asm volatile("s_waitcnt vmcnt(" #n ")" ::: "memory")
#define PG8_WAIT_L(n) asm volatile("s_waitcnt lgkmcnt(" #n ")" ::: "memory")
#define PG8_BAR __builtin_amdgcn_s_barrier()
#define PG8_SCHED __builtin_amdgcn_sched_barrier(0)
    Unit cur, nxt; int ui = 0;
    if (!S.next(0, cur)) return;
    f32x4 acc[2][2][4][2];
#pragma unroll
    for (int a = 0; a < 2; ++a)
#pragma unroll
        for (int b = 0; b < 2; ++b)
#pragma unroll
            for (int m = 0; m < 4; ++m)
#pragma unroll
                for (int n = 0; n < 2; ++n) acc[a][b][m][n] = (f32x4){0.f, 0.f, 0.f, 0.f};
    bf16x8 At[4][2], B0[2][2], B1[2][2];
    const char* cA = (const char*)g.A + (size_t)cur.pm * tstep; const char* cB = (const char*)g.Bt + (size_t)cur.pn * tstep;
    S.a_ready(cur);
    if constexpr (SP2) {
        PG8_STAGE(PG8_SB(0, 0), cB, voffB); PG8_STAGE(PG8_SB(0, 1), cB + hstep, voffB); PG8_STAGE(PG8_SA(0, 0), cA, voffA); PG8_STAGE(PG8_SA(0, 1), cA + hstep, voffA);
        if (wr == 1) PG8_BAR;
        PG8_WAIT_V(2); PG8_BAR;
        PG8_STAGE(PG8_SB(1, 0), cB + kstep, voffB); PG8_STAGE(PG8_SA(1, 0), cA + kstep, voffA); PG8_STAGE(PG8_SB(1, 1), cB + hstep + kstep, voffB);
        PG8_WAIT_V(6); PG8_BAR;
    } else {
        PG8_STAGE(PG8_SB(0, 0), cB, voffB); PG8_STAGE(PG8_SA(0, 0), cA, voffA); PG8_STAGE(PG8_SB(0, 1), cB + hstep, voffB); PG8_STAGE(PG8_SA(0, 1), cA + hstep, voffA);
        if (wr == 1) PG8_BAR;
        PG8_WAIT_V(4); PG8_BAR;
        PG8_STAGE(PG8_SB(1, 0), cB + kstep, voffB); PG8_STAGE(PG8_SA(1, 0), cA + kstep, voffA); PG8_STAGE(PG8_SB(1, 1), cB + hstep + kstep, voffB);
        PG8_WAIT_V(6); PG8_BAR;
    }
    for (;;) {
        const bool has_next = S.next(ui + 1, nxt);
        const char* nA = has_next ? (const char*)g.A + (size_t)nxt.pm * tstep : cA; const char* nB = has_next ? (const char*)g.Bt + (size_t)nxt.pn * tstep : cB;
        for (int t = 0; t < nt; t += 2) {
            const bool last = (t == nt - 2);
            const char* a1 = cA + (size_t)(t + 1) * kstep;
            const char* a2 = last ? nA : cA + (size_t)(t + 2) * kstep; const char* b2 = last ? nB : cB + (size_t)(t + 2) * kstep;
            const char* a3 = a2 + kstep; const char* b3 = b2 + kstep;
            if (last && has_next) S.a_ready(nxt);
            if constexpr (SP2) {
            PG8_LDB(B0, 0, 0); PG8_LDB(B1, 0, 1); PG8_SCHED; PG8_LDA(At, 0, 0); PG8_STAGE(PG8_SA(1, 1), a1 + hstep, voffA);
            PG8_WAIT_V(8); PG8_WAIT_L(0); PG8_BAR; PG8_MMA(0, 0, At, B0); PG8_MMA(0, 1, At, B1); PG8_BAR; PG8_SCHED;
            PG8_LDA(At, 0, 1); PG8_STAGE(PG8_SB(0, 0), b2, voffB); PG8_STAGE(PG8_SB(0, 1), b2 + hstep, voffB); PG8_STAGE(PG8_SA(0, 0), a2, voffA);
            PG8_WAIT_V(8); PG8_WAIT_L(0); PG8_BAR; PG8_MMA(1, 0, At, B0); PG8_MMA(1, 1, At, B1); PG8_BAR; PG8_SCHED;
            PG8_LDB(B0, 1, 0); PG8_LDB(B1, 1, 1); PG8_SCHED; PG8_LDA(At, 1, 0); PG8_STAGE(PG8_SA(0, 1), a2 + hstep, voffA);
            PG8_WAIT_V(8); PG8_WAIT_L(0); PG8_BAR; PG8_MMA(0, 0, At, B0); PG8_MMA(0, 1, At, B1); PG8_BAR; PG8_SCHED;
            PG8_LDA(At, 1, 1); PG8_STAGE(PG8_SB(1, 0), b3, voffB); PG8_STAGE(PG8_SB(1, 1), b3 + hstep, voffB); PG8_STAGE(PG8_SA(1, 0), a3, voffA);
            PG8_WAIT_V(8); PG8_WAIT_L(0); PG8_BAR; PG8_MMA(1, 0, At, B0); PG8_MMA(1, 1, At, B1); PG8_BAR; PG8_SCHED;
            } else {
            PG8_LDB(B0, 0, 0); PG8_SCHED; PG8_LDA(At, 0, 0); PG8_STAGE(PG8_SA(1, 1), a1 + hstep, voffA);
            PG8_WAIT_L(8); PG8_BAR; PG8_WAIT_L(0); PG8_MMA(0, 0, At, B0); PG8_BAR; PG8_SCHED;
            PG8_LDB(B1, 0, 1); PG8_STAGE(PG8_SB(0, 0), b2, voffB);
            PG8_BAR; PG8_WAIT_L(0); PG8_MMA(0, 1, At, B1); PG8_BAR;
            PG8_LDA(At, 0, 1); PG8_STAGE(PG8_SA(0, 0), a2, voffA);
            PG8_BAR; PG8_WAIT_L(0); PG8_MMA(1, 0, At, B0); PG8_BAR; PG8_SCHED;
            PG8_STAGE(PG8_SB(0, 1), b2 + hstep, voffB);
            PG8_WAIT_V(6); PG8_BAR; PG8_MMA(1, 1, At, B1); PG8_BAR;
            PG8_LDB(B0, 1, 0); PG8_SCHED; PG8_LDA(At, 1, 0); PG8_STAGE(PG8_SA(0, 1), a2 + hstep, voffA);
            PG8_WAIT_L(8); PG8_BAR; PG8_WAIT_L(0); PG8_MMA(0, 0, At, B0); PG8_BAR; PG8_SCHED;
            PG8_LDB(B1, 1, 1); PG8_STAGE(PG8_SB(1, 0), b3, voffB);
            PG8_BAR; PG8_WAIT_L(0); PG8_MMA(0, 1, At, B1); PG8_BAR;
            PG8_LDA(At, 1, 1); PG8_STAGE(PG8_SA(1, 0), a3, voffA);
            PG8_BAR; PG8_WAIT_L(0); PG8_MMA(1, 0, At, B0); PG8_BAR; PG8_SCHED;
            PG8_STAGE(PG8_SB(1, 1), b3 + hstep, voffB);
            PG8_WAIT_V(6); PG8_BAR; PG8_MMA(1, 1, At, B1); PG8_BAR;
            }
        }
        if constexpr (ALIGN_EPI) { if (wr == 0) PG8_BAR; }
        if constexpr (!Epi::AFTER_DRAIN) { E(acc, cur, wr, wc, fr, fq); S.done(cur); }
        if (!has_next) break;
#pragma unroll
        for (int a = 0; a < 2; ++a)
#pragma unroll
            for (int b = 0; b < 2; ++b)
#pragma unroll
                for (int m = 0; m < 4; ++m)
#pragma unroll
                    for (int n = 0; n < 2; ++n) acc[a][b][m][n] = (f32x4){0.f, 0.f, 0.f, 0.f};
        cur = nxt; cA = nA; cB = nB; ++ui;
        if constexpr (ALIGN_EPI) { if (wr == 1) PG8_BAR; }
    }
    PG8_WAIT_V(0);
    if constexpr (!ALIGN_EPI) { if (wr == 0) PG8_BAR; }
    PG8_BAR;
    if constexpr (Epi::AFTER_DRAIN) { E.fused(acc, cur, wr, wc, fr, fq, lds, wid, lane); S.done(cur); }
#undef PG8_SA
#undef PG8_SB
#undef PG8_STAGE
#undef PG8_LDA
#undef PG8_LDB
#undef PG8_MMA
#undef PG8_WAIT_V
#undef PG8_WAIT_L
#undef PG8_BAR
#undef PG8_SCHED
}
}
#define GAS __attribute__((address_space(1)))
#define LAS __attribute__((address_space(3)))
typedef unsigned short bf16;
typedef unsigned v4u __attribute__((ext_vector_type(4)));
typedef float f32x4 __attribute__((ext_vector_type(4)));
typedef short bf16x8 __attribute__((ext_vector_type(8)));
typedef GAS unsigned gu32;
typedef GAS unsigned long long gu64;
#define RLX_AGENT __ATOMIC_RELAXED, __HIP_MEMORY_SCOPE_AGENT
#define LDS_WAIT() asm volatile("s_waitcnt lgkmcnt(0)" ::: "memory")
#define VM_WAIT() asm volatile("s_waitcnt vmcnt(0)" ::: "memory")
__device__ __forceinline__ unsigned long long rt() { return __builtin_amdgcn_s_memrealtime(); }
__device__ __forceinline__ unsigned f2bf(float f) { unsigned u = __builtin_bit_cast(unsigned, f); return (u + 0x7fffu + ((u >> 16) & 1u)) >> 16; }
__device__ __forceinline__ unsigned pk2(float lo, float hi) { return f2bf(lo) | (f2bf(hi) << 16); }

#define XB_TMO      128
#define XB_XCNT(j)  (256  + 64 * (j))
#define XB_XSUB(j)  (1280 + 64 * (j))
#define XB_XGEN(j)  (2304 + 64 * (j))
#define XB_TOP      3328
#define XB_TOPGEN   3392
#define XCD_BAR_WORDS 3456
#define XB_SPIN_CAP (1u << 18)

__device__ __forceinline__ unsigned xb_ld(unsigned* p)              { return __hip_atomic_load(p, __ATOMIC_RELAXED, __HIP_MEMORY_SCOPE_AGENT); }
__device__ __forceinline__ unsigned xb_add(unsigned* p, unsigned v) { return __hip_atomic_fetch_add(p, v, __ATOMIC_RELAXED, __HIP_MEMORY_SCOPE_AGENT); }
__device__ __forceinline__ unsigned xb_xcc_id() { return (unsigned)__builtin_amdgcn_s_getreg((3 << 11) | 20) & 0xFu; }
#define XB_SPIN(cond, bar) do { unsigned _sp = 0; while (cond) { __builtin_amdgcn_s_sleep(1); \
    if ((++_sp & 255u) == 0u) { if (xb_ld(&(bar)[XB_TMO])) break; if (_sp > XB_SPIN_CAP) { atomicAdd(&(bar)[XB_TMO], 1u); break; } } } } while (0)

struct XcdBarrier {
    unsigned* bar; unsigned x;
    volatile LAS unsigned* st;
};

__device__ __forceinline__ XcdBarrier xcd_barrier_post(unsigned* bar, volatile LAS unsigned* st) {
    XcdBarrier b; b.bar = bar; b.x = xb_xcc_id(); b.st = st;
    if (threadIdx.x == 0) (void)xb_add(&bar[XB_XCNT(b.x)], 1u);
    return b;
}
__device__ __forceinline__ void xcd_barrier_complete(unsigned* bar, unsigned x, unsigned& nloc, unsigned& nx) {
    const unsigned G = gridDim.x * gridDim.y * gridDim.z;
    unsigned sum, cnt, mine, sp = 0u;
    for (;;) {
        sum = 0u; cnt = 0u; mine = 0u;
#pragma unroll
        for (unsigned j = 0; j < 16; ++j) { const unsigned c = xb_ld(&bar[XB_XCNT(j)]); sum += c; cnt += (c > 0u) ? 1u : 0u; mine = (j == x) ? c : mine; }
        if (sum == G) break;
        __builtin_amdgcn_s_sleep(1);
        if ((++sp & 255u) == 0u) { if (xb_ld(&bar[XB_TMO])) break; if (sp > XB_SPIN_CAP) { atomicAdd(&bar[XB_TMO], 1u); break; } }
    }
    nloc = mine > 0u ? mine : 1u; nx = cnt > 0u ? cnt : 1u;
}

__device__ __forceinline__ void xcd_barrier(const XcdBarrier& b) {
    asm volatile("s_waitcnt vmcnt(0)" ::: "memory");
    __syncthreads();
    if (threadIdx.x == 0) {
        unsigned* bar = b.bar;
        __builtin_amdgcn_s_waitcnt(0);
        unsigned nloc = b.st[0], nx = b.st[1];
        if (nloc == 0u) { xcd_barrier_complete(bar, b.x, nloc, nx); b.st[0] = nloc; b.st[1] = nx; }
        const unsigned old = xb_add(&bar[XB_XSUB(b.x)], 1u);
        const unsigned gen = old / nloc;
        if (old + 1u == (gen + 1u) * nloc) {
            __builtin_amdgcn_fence(__ATOMIC_RELEASE, "agent");
            asm volatile("s_waitcnt vmcnt(0)" ::: "memory");
            const unsigned og = xb_add(&bar[XB_TOP], 1u);
            const unsigned tg = og / nx;
            if (og + 1u == (tg + 1u) * nx) xb_add(&bar[XB_TOPGEN], 1u);
            else XB_SPIN(xb_ld(&bar[XB_TOPGEN]) == tg, bar);
            __builtin_amdgcn_fence(__ATOMIC_ACQUIRE, "agent");
            xb_add(&bar[XB_XGEN(b.x)], 1u);
            asm volatile("s_waitcnt vmcnt(0)" ::: "memory");
        } else {
            XB_SPIN(xb_ld(&bar[XB_XGEN(b.x)]) == gen, bar);
            __builtin_amdgcn_fence(__ATOMIC_ACQUIRE, "agent");
            asm volatile("s_waitcnt vmcnt(0)" ::: "memory");
        }
    }
    __syncthreads();
}

constexpr int NWAVES = 8;
constexpr int DM = 2048, TP = 8192, NSMP = 1024, NTOK = 9216, DFF = 8192, PLED = 256, NG = 128, NPST = 64, NKV = 4, HD = 128, NH = 16, PASTL = 2048, NPG = 16, DECB = 128, DECT = 8;
constexpr float LN_EPS = 1e-5f, DN_ALPHA = 1.41421356237f, QSCALE = 0.12751743082459868f, LOG2E = 1.4426950408889634f;
constexpr size_t O_Y = 0, O_SRE_P = 18874368, O_SIM_P = 18882560, O_K_P = 18890752, O_V_P = 23085056, O_SRE_S = 27279360, O_SIM_S = 28327936, O_K_S = 29376512, O_V_S = 29900800, O_END = 30425088;
constexpr size_t MiB = 1u << 20;
constexpr size_t WS_CTL = 0, CTL_ZERO_BYTES = 2 * MiB;
constexpr size_t WS_STAT = 1 * MiB, WS_CV = 1 * MiB + 512 * 1024;
constexpr int CV_M1_0 = 0, CV_PL_0 = 16384, CV_KVQ = 20480, CV_M1_1 = 26624, CV_PL_1 = 43008, CV_END = 47104;
constexpr size_t WS_WG = 2 * MiB, WS_WO5 = 10 * MiB, WS_W1_0 = 18 * MiB, WS_W2_0 = 50 * MiB, WS_WPP_0 = 82 * MiB, WS_WPG_0 = 83 * MiB, WS_WKVQ = 91 * MiB, WS_WO = 103 * MiB,
                 WS_W1_1 = 111 * MiB, WS_W2_1 = 143 * MiB, WS_WPP_1 = 175 * MiB, WS_WPG_1 = 176 * MiB;
constexpr size_t WS_PB = 184 * MiB, WS_E0 = 194 * MiB, WS_E1 = 230 * MiB, WS_G = 266 * MiB, WS_T = 302 * MiB, WS_R = 338 * MiB, WS_X = 410 * MiB, WS_XB = 482 * MiB, WS_H = 518 * MiB;
constexpr size_t WS_KB = 662 * MiB, WS_VB = 670 * MiB, WS_VT = 678 * MiB, WS_QB = 686 * MiB, WS_OB = 722 * MiB, WS_HS = 758 * MiB, WS_END = 1334 * MiB;
constexpr int CW_TMO = 0, CW_BAR = 4096;
constexpr int CW_ATQ = 201000;
constexpr int AT_SMP_R0 = 22;
constexpr int CW_MRGL = 210000;
constexpr int CW_MRG = 200000;
constexpr int RING_OFF = 0, RING_BYTES = 131072, LDSCTL_OFF = RING_BYTES, MISC_OFF = LDSCTL_OFF + 320, LDS_BYTES = 147456;

__device__ __forceinline__ float wave_sum(float v) {
#pragma unroll
    for (int o = 1; o < 64; o <<= 1) v += __shfl_xor(v, o);
    return v;
}
__device__ __forceinline__ float bflo(unsigned w) { return __uint_as_float(w << 16); }
__device__ __forceinline__ float bfhi(unsigned w) { return __uint_as_float(w & 0xffff0000u); }
typedef float f32x2_t __attribute__((ext_vector_type(2))); typedef __bf16 bf16x2_t __attribute__((ext_vector_type(2)));
__device__ __forceinline__ unsigned cvtpk(float lo, float hi) { f32x2_t v = {lo, hi}; bf16x2_t b = __builtin_convertvector(v, bf16x2_t); return __builtin_bit_cast(unsigned, b); }
__device__ __forceinline__ float gelu_tanh(float v) { const float a = v * (2.3022082f + 0.10294324f * (v * v)); return v * __builtin_amdgcn_rcpf(1.f + __builtin_amdgcn_exp2f(-a)); }

__device__ __forceinline__ void p0_transpose_item(const float* W, int K, int N, bf16* WT, int row_off, LAS float* scr, int item, int lane, const float* gv = nullptr, const float* bv = nullptr, float* c1 = nullptr, float* c2 = nullptr) {
    const int nblk = N / 32, kb = item / nblk, nb = item % nblk, k0 = 64 * kb, n0 = 32 * nb;
#pragma unroll 8
    for (int i = 0; i < 32; ++i) { const int kk = 2 * i + (lane >> 5); scr[kk * 33 + (lane & 31)] = W[(size_t)(k0 + kk) * N + n0 + (lane & 31)]; }
    LDS_WAIT(); asm volatile("" ::: "memory");
    if (gv) { const int nn = lane & 31, hf = lane >> 5; float s1 = 0.f, s2 = 0.f;
#pragma unroll 8
        for (int k2 = 0; k2 < 32; ++k2) { const int kk = hf * 32 + k2; const float w = scr[kk * 33 + nn]; s1 += __uint_as_float(f2bf(w * gv[k0 + kk]) << 16); s2 += w * bv[k0 + kk]; }
        s1 += __shfl_xor(s1, 32); s2 += __shfl_xor(s2, 32);
        if (lane < 32) { atomicAdd(c1 + row_off + n0 + nn, s1); atomicAdd(c2 + row_off + n0 + nn, s2); } }
    const int c = lane & 7;
    float g8[8];
#pragma unroll
    for (int j = 0; j < 8; ++j) g8[j] = gv ? gv[k0 + 8 * c + j] : 1.f;
#pragma unroll
    for (int j = 0; j < 4; ++j) { const int n = (lane >> 3) + 8 * j; const LAS float* s = scr + (8 * c) * 33 + n;
        v4u o; o.x = pk2(s[0 * 33] * g8[0], s[1 * 33] * g8[1]); o.y = pk2(s[2 * 33] * g8[2], s[3 * 33] * g8[3]); o.z = pk2(s[4 * 33] * g8[4], s[5 * 33] * g8[5]); o.w = pk2(s[6 * 33] * g8[6], s[7 * 33] * g8[7]);
        *(GAS v4u*)(WT + (size_t)(row_off + n0 + n) * K + k0 + 8 * c) = o; }
    LDS_WAIT(); asm volatile("" ::: "memory");
}

struct Args { const void* in[34]; float* out; unsigned char* ws; int ph_lo, ph_hi, li, pad; };
typedef const __attribute__((address_space(4))) Args* KArgs;
__device__ __forceinline__ KArgs kargs() { KArgs p = (KArgs)__builtin_amdgcn_kernarg_segment_ptr(); asm volatile("" : "+s"(p)); return p; }
#define INP(T, i) ((const T*)A->in[i])
#define WSP(T, off) ((T*)(ws + (off)))

__device__ __forceinline__ void s5_setup(KArgs A, int g, int p, float& ar, float& ai, float (&bbr)[16], float (&bbi)[16]) {
    const float* lam_re = INP(float, 9); const float* lam_im = INP(float, 10); const float* log_dt = INP(float, 11);
    const float* b_re = INP(float, 12); const float* b_im = INP(float, 13);
    const double dt = exp((double)log_dt[g]); const double lr = (double)lam_re[g * 64 + p], li = (double)lam_im[g * 64 + p];
    const double mag = exp(lr * dt); double sn, cs; sincos(li * dt, &sn, &cs);
    const double abr = mag * cs, abi = mag * sn, den = lr * lr + li * li, nr = abr - 1.0;
    const double fr = (nr * lr + abi * li) / den, fi = (abi * lr - nr * li) / den;
    ar = (float)abr; ai = (float)abi;
    const float* br = b_re + ((size_t)g * 64 + p) * 16; const float* bi = b_im + ((size_t)g * 64 + p) * 16;
#pragma unroll
    for (int c = 0; c < 16; ++c) { const double x = (double)br[c], y = (double)bi[c]; bbr[c] = (float)(fr * x - fi * y); bbi[c] = (float)(fr * y + fi * x); }
}


constexpr int S5_L = 256, S5_NCH = TP / S5_L, S5_SB = S5_L / 16, S5_TS = 132;
constexpr int S5_WAVE_LDS = 10240;
constexpr int S5T_PAR = 8 * S5_WAVE_LDS, S5T_BOP = S5T_PAR + 1024, S5T_COP = S5T_BOP + 16384, S5T_F = S5T_COP + 8192;
static_assert(S5T_F + 512 <= RING_BYTES, "S5 LDS tables");
typedef float f32x4s __attribute__((ext_vector_type(4)));
__device__ __forceinline__ unsigned hi_pair(float a, float b) { return cvtpk(a, b); }
__device__ __forceinline__ unsigned lo_pair(float a, float b, unsigned hp) { return cvtpk(a - bflo(hp), b - bfhi(hp)); }
__device__ __forceinline__ f32x4s s5_setup2(KArgs A, int g, int p, LAS float* tab) {
    const float* lam_re = INP(float, 9); const float* lam_im = INP(float, 10); const float* log_dt = INP(float, 11);
    const double dt = exp((double)log_dt[g]); const double lr = (double)lam_re[g * 64 + p], li = (double)lam_im[g * 64 + p];
    const double mag = exp(lr * dt); double sn, cs; sincos(li * dt, &sn, &cs);
    const double abr = mag * cs, abi = mag * sn, den = lr * lr + li * li, nr = abr - 1.0;
    const double fr = (nr * lr + abi * li) / den, fi = (abi * lr - nr * li) / den;
    const double magL = exp(lr * dt * (double)S5_L); double snL, csL; sincos(li * dt * (double)S5_L, &snL, &csL);
    tab[2 * p] = (float)fr; tab[2 * p + 1] = (float)fi;
    return (f32x4s){(float)abr, (float)abi, (float)(magL * csL), (float)(magL * snL)};
}
template <bool WITH_C> __device__ __forceinline__ void s5_operands(KArgs A, int g, int lane, LAS float* tab, f32x4s& P, bf16x8 (&bop)[16], bf16x8 (&cop)[8]) {
    const float* b_re = INP(float, 12); const float* b_im = INP(float, 13); const float* c_re = INP(float, 14); const float* c_im = INP(float, 15);
    P = s5_setup2(A, g, lane, tab);
    const int n = lane & 15, kq = lane >> 4;
#pragma unroll
    for (int nb = 0; nb < 8; ++nb) { const int p = (nb & 3) * 16 + n; const float fr = tab[2 * p], fi = tab[2 * p + 1]; float val[8];
#pragma unroll
        for (int j = 0; j < 8; ++j) { const int ch = (8 * kq + j) & 15; const float x = b_re[((size_t)g * 64 + p) * 16 + ch], y = b_im[((size_t)g * 64 + p) * 16 + ch]; val[j] = (nb < 4) ? fr * x - fi * y : fr * y + fi * x; }
        v4u h, l;
        h.x = hi_pair(val[0], val[1]); h.y = hi_pair(val[2], val[3]); h.z = hi_pair(val[4], val[5]); h.w = hi_pair(val[6], val[7]);
        l.x = lo_pair(val[0], val[1], h.x); l.y = lo_pair(val[2], val[3], h.y); l.z = lo_pair(val[4], val[5], h.z); l.w = lo_pair(val[6], val[7], h.w);
        if (kq >= 2) l = (v4u){0u, 0u, 0u, 0u};
        bop[2 * nb] = __builtin_bit_cast(bf16x8, h); bop[2 * nb + 1] = __builtin_bit_cast(bf16x8, l); }
    if (WITH_C) {
#pragma unroll
        for (int ks = 0; ks < 4; ++ks) { float val[8];
#pragma unroll
            for (int j = 0; j < 8; ++j) { const int k = 32 * ks + 8 * kq + j; const size_t ci = ((size_t)g * 16 + n) * 64 + (k & 63); val[j] = (k < 64) ? c_re[ci] : -c_im[ci]; }
            v4u h, l;
            h.x = hi_pair(val[0], val[1]); h.y = hi_pair(val[2], val[3]); h.z = hi_pair(val[4], val[5]); h.w = hi_pair(val[6], val[7]);
            l.x = lo_pair(val[0], val[1], h.x); l.y = lo_pair(val[2], val[3], h.y); l.z = lo_pair(val[4], val[5], h.z); l.w = lo_pair(val[6], val[7], h.w);
            cop[2 * ks] = __builtin_bit_cast(bf16x8, h); cop[2 * ks + 1] = __builtin_bit_cast(bf16x8, l); } }
}
__device__ __forceinline__ bf16x8 s5_aop(f32x4 xa0, f32x4 xa1, int kq) {
    v4u h; h.x = hi_pair(xa0.x, xa0.y); h.y = hi_pair(xa0.z, xa0.w); h.z = hi_pair(xa1.x, xa1.y); h.w = hi_pair(xa1.z, xa1.w);
    v4u l; l.x = lo_pair(xa0.x, xa0.y, h.x); l.y = lo_pair(xa0.z, xa0.w, h.y); l.z = lo_pair(xa1.x, xa1.y, h.z); l.w = lo_pair(xa1.z, xa1.w, h.w);
    const v4u r = (kq < 2) ? h : l; return __builtin_bit_cast(bf16x8, r);
}
__device__ __forceinline__ void s5_bu(bf16x8 aop, const bf16x8 (&bop)[16], LAS float* tile, int lane) {
    f32x4s acc[8];
#pragma unroll
    for (int nb = 0; nb < 8; ++nb) acc[nb] = __builtin_amdgcn_mfma_f32_16x16x32_bf16(aop, bop[2 * nb], (f32x4s){0.f, 0.f, 0.f, 0.f}, 0, 0, 0);
#pragma unroll
    for (int nb = 0; nb < 8; ++nb) acc[nb] = __builtin_amdgcn_mfma_f32_16x16x32_bf16(aop, bop[2 * nb + 1], acc[nb], 0, 0, 0);
#pragma unroll
    for (int nb = 0; nb < 8; ++nb)
#pragma unroll
        for (int i = 0; i < 4; ++i) tile[(4 * (lane >> 4) + i) * S5_TS + nb * 16 + (lane & 15)] = acc[nb][i];
}

struct Ctx { LAS unsigned char* L; int lo, hi, gw, NGW, G, bx, lane, wave, tid; };
#define IN(k) (C.lo <= (k) && (k) < C.hi)
#define BOTH(k) (IN(k) && IN((k) + 1))
#define SEAM(k) do { if (BOTH(k)) xcd_barrier(bar); } while (0)

typedef float f32x16 __attribute__((ext_vector_type(16)));
constexpr int AT_KP = 256, AT_VP = 128, AT_KBYTES = 64 * AT_KP, AT_VBYTES = 128 * AT_VP, AT_BUF = AT_KBYTES + AT_VBYTES;
static_assert(4 * AT_BUF <= RING_BYTES, "attention LDS");
__device__ __forceinline__ bf16x8 pack8(const f32x16& x, int s) { v4u w; w.x = cvtpk(x[8 * s + 0], x[8 * s + 1]); w.y = cvtpk(x[8 * s + 2], x[8 * s + 3]); w.z = cvtpk(x[8 * s + 4], x[8 * s + 5]); w.w = cvtpk(x[8 * s + 6], x[8 * s + 7]); return __builtin_bit_cast(bf16x8, w); }
#define AT_SB() __builtin_amdgcn_sched_barrier(0)
template <int VBLK> __device__ __forceinline__ void at_step(const LAS unsigned char* kb, const LAS unsigned char* vb, int kq0, int kshi, int vq0, int vsw, const bf16x8 (&qf)[8], const bf16x8 (&ntri)[2],
                                                            f32x16 (&o)[4], f32x16& z, float& Rb, v4u& wp0, v4u& wp1, float cb, int r32) {
#define AT_KF(ks_) (*(const LAS bf16x8*)(kb + kq0 + (((ks_) ^ kshi) << 5)))
#define AT_VF(i_) (*(const LAS bf16x8*)(vb + vq0 + ((i_) & 3) * 32 * AT_VP + (((4 * VBLK + 2 * ((i_) >> 2)) ^ vsw) << 4)))
#define AT_SPC(p_) do { const float e0_ = __builtin_amdgcn_exp2f(z[2 * (p_)]), e1_ = __builtin_amdgcn_exp2f(z[2 * (p_) + 1]); \
        la = __builtin_amdgcn_logf(__builtin_fmaf(e0_, cb, 1.f)); lb = __builtin_amdgcn_logf(__builtin_fmaf(e1_, cb, 1.f)); \
        z[2 * (p_)] -= Rb; z[2 * (p_) + 1] -= Rb; asm volatile("" : "+v"(la), "+v"(lb), "+v"(z[2 * (p_)]), "+v"(z[2 * (p_) + 1])); } while (0)
#define AT_SPK(p_) do { unsigned w_ = cvtpk(la, lb); asm volatile("" : "+v"(w_)); if ((p_) < 4) s0[(p_) & 3] = w_; else s1[(p_) & 3] = w_; } while (0)
#define AT_EXC(p_, ea_, eb_) do { ea_ = __builtin_amdgcn_exp2f(ex[2 * (p_)]); eb_ = __builtin_amdgcn_exp2f(ex[2 * (p_) + 1]); asm volatile("" : "+v"(ea_), "+v"(eb_)); } while (0)
#define AT_EXK(p_, ea_, eb_) do { unsigned w_ = cvtpk(ea_, eb_); asm volatile("" : "+v"(w_)); if ((p_) < 4) n0[(p_) & 3] = w_; else n1[(p_) & 3] = w_; } while (0)
    v4u s0, s1, n0, n1;
    const float zr0 = z[0];
    bf16x8 vfa = AT_VF(0), vfb = AT_VF(1);
    float la, lb, ea, eb, fa, fb;
    AT_SPC(0);
    AT_SB();
    bf16x8 kfa, kfb;
#pragma unroll
    for (int i = 0; i < 8; ++i) {
        bf16x8 vfc = vfb;
        if (i + 2 < 8) vfc = AT_VF(i + 2);
        if (i == 6) kfa = AT_KF(0);
        if (i == 7) kfb = AT_KF(1);
        o[i & 3] = __builtin_amdgcn_mfma_f32_32x32x16_bf16(vfa, __builtin_bit_cast(bf16x8, i < 4 ? wp0 : wp1), o[i & 3], 0, 0, 0);
        AT_SPK(i);
        if (i < 7) AT_SPC(i + 1);
        vfa = vfb; vfb = vfc;
        AT_SB();
    }
    f32x16 ex = __builtin_amdgcn_mfma_f32_32x32x16_bf16(ntri[0], __builtin_bit_cast(bf16x8, s0), z, 0, 0, 0);
    ex = __builtin_amdgcn_mfma_f32_32x32x16_bf16(ntri[1], __builtin_bit_cast(bf16x8, s1), ex, 0, 0, 0);
    f32x16 zn;
#pragma unroll
    for (int r = 0; r < 16; ++r) zn[r] = 0.f;
    {   bf16x8 kfc = AT_KF(2), kfd = AT_KF(3);
        zn = __builtin_amdgcn_mfma_f32_32x32x16_bf16(kfa, qf[0], zn, 0, 0, 0);
        zn = __builtin_amdgcn_mfma_f32_32x32x16_bf16(kfb, qf[1], zn, 0, 0, 0);
        kfa = kfc; kfb = kfd; }
    AT_SB();
    Rb = __shfl(zr0 - ex[0], r32);
#pragma unroll
    for (int i = 2; i < 8; ++i) {
        bf16x8 kfc = kfb;
        if (i + 2 < 8) kfc = AT_KF(i + 2);
        zn = __builtin_amdgcn_mfma_f32_32x32x16_bf16(kfa, qf[i], zn, 0, 0, 0);
        if (i == 2) { AT_EXC(0, ea, eb); AT_EXC(1, fa, fb); } else if (i & 1) { AT_EXK(i - 3, ea, eb); AT_EXC(i - 1, ea, eb); } else { AT_EXK(i - 3, fa, fb); AT_EXC(i - 1, fa, fb); }
        kfa = kfb; kfb = kfc;
        AT_SB();
    }
    AT_EXK(5, fa, fb); AT_EXC(7, fa, fb); AT_EXK(6, ea, eb); AT_EXK(7, fa, fb);
    AT_SB();
    wp0 = n0; wp1 = n1; z = zn;
#undef AT_KF
#undef AT_VF
#undef AT_SPC
#undef AT_SPK
#undef AT_EXC
#undef AT_EXK
}
__device__ __forceinline__ void attn_prompt_unit(const Ctx& C, const bf16* Qb, const bf16* Kb, const bf16* Vt, bf16* Ob, const float* sb_bias, int kvh, int qb) {
    LAS unsigned char* const L = C.L; int lane = C.lane; const int wave = C.wave;
    asm volatile("" : "+v"(lane));
    const int g = wave >> 1, sq = wave & 1, h = kvh * 4 + g, r32 = lane & 31, hh = lane >> 5;
    const int t = 64 * qb + 32 * sq + r32;
    bf16x8 qf[8];
#pragma unroll
    for (int ks = 0; ks < 8; ++ks) qf[ks] = *(const bf16x8*)(Qb + (size_t)t * DM + h * HD + 16 * ks + 8 * hh);
    const float bias2 = sb_bias[h] * LOG2E;
    bf16x8 tri[2];
#pragma unroll
    for (int s = 0; s < 2; ++s)
#pragma unroll
        for (int jj = 0; jj < 8; ++jj) { const int key = 16 * s + 8 * (jj >> 2) + 4 * hh + (jj & 3); tri[s][jj] = (key >= r32) ? (short)0x3F80 : (short)0; }
    f32x16 o[4];
#pragma unroll
    for (int db = 0; db < 4; ++db)
#pragma unroll
        for (int r = 0; r < 16; ++r) o[db][r] = 0.f;
    float R = 0.f;
    const bf16* kg = Kb + kvh * HD; const bf16* vg = Vt + (size_t)kvh * HD * TP;
    const int krr = lane >> 4, kpc = lane & 15, vrr = lane >> 3, vpc = lane & 7;
#define AT_DMA(kt_, buf_) do { _Pragma("unroll") for (int i_ = 0; i_ < 2; ++i_) { const int I_ = 2 * wave + i_; \
        { const int row_ = 4 * I_ + krr; const int c_ = kpc ^ (row_ & 15); __builtin_amdgcn_global_load_lds((const unsigned*)(kg + (size_t)(64 * (kt_) + row_) * 512 + c_ * 8), (LAS unsigned*)(L + (buf_) * AT_BUF + I_ * 1024), 16, 0, 0); } \
        { const int row_ = 8 * I_ + vrr; const int c_ = vpc ^ ((row_ >> 1) & 7); __builtin_amdgcn_global_load_lds((const unsigned*)(vg + (size_t)row_ * TP + 64 * (kt_) + c_ * 8), (LAS unsigned*)(L + (buf_) * AT_BUF + AT_KBYTES + I_ * 1024), 16, 0, 0); } } } while (0)
    __syncthreads();
    AT_DMA(qb, qb & 3);
    if (qb >= 1) AT_DMA(qb - 1, (qb - 1) & 3);
    if (qb >= 2) AT_DMA(qb - 2, (qb - 2) & 3);
    asm volatile("s_waitcnt vmcnt(0)" ::: "memory"); __syncthreads();
    {
        const LAS unsigned char* KB = L + (qb & 3) * AT_BUF; const LAS unsigned char* VB = KB + AT_KBYTES;
#pragma unroll
        for (int kb = 1; kb >= 0; --kb) {
            if (kb > sq) continue;
            f32x16 z;
#pragma unroll
            for (int r = 0; r < 16; ++r) z[r] = bias2;
#pragma unroll
            for (int ks = 0; ks < 8; ++ks) { const bf16x8 kf = *(const LAS bf16x8*)(KB + (32 * kb + r32) * AT_KP + (((2 * ks + hh) ^ (r32 & 15)) << 4)); z = __builtin_amdgcn_mfma_f32_32x32x16_bf16(kf, qf[ks], z, 0, 0, 0); }
            if (kb == sq) {
#pragma unroll
                for (int r = 0; r < 16; ++r) { const int kk = (r & 3) + 8 * (r >> 2) + 4 * hh; if (kk >= r32) z[r] = -INFINITY; } }
            f32x16 sp;
#pragma unroll
            for (int r = 0; r < 16; ++r) sp[r] = __builtin_amdgcn_logf(1.f + __builtin_amdgcn_exp2f(z[r]));
            const bf16x8 sp0 = pack8(sp, 0), sp1 = pack8(sp, 1);
            f32x16 cum;
#pragma unroll
            for (int r = 0; r < 16; ++r) cum[r] = R;
            cum = __builtin_amdgcn_mfma_f32_32x32x16_bf16(tri[0], sp0, cum, 0, 0, 0);
            cum = __builtin_amdgcn_mfma_f32_32x32x16_bf16(tri[1], sp1, cum, 0, 0, 0);
#pragma unroll
            for (int r = 0; r < 16; ++r) sp[r] = __builtin_amdgcn_exp2f(z[r] - cum[r]);
            const bf16x8 w0 = pack8(sp, 0), w1 = pack8(sp, 1);
#pragma unroll
            for (int db = 0; db < 4; ++db) {
                const bf16x8 v0 = *(const LAS bf16x8*)(VB + (32 * db + r32) * AT_VP + (((4 * kb + hh) ^ ((r32 >> 1) & 7)) << 4));
                const bf16x8 v1 = *(const LAS bf16x8*)(VB + (32 * db + r32) * AT_VP + (((4 * kb + 2 + hh) ^ ((r32 >> 1) & 7)) << 4));
                o[db] = __builtin_amdgcn_mfma_f32_32x32x16_bf16(v0, w0, o[db], 0, 0, 0);
                o[db] = __builtin_amdgcn_mfma_f32_32x32x16_bf16(v1, w1, o[db], 0, 0, 0); }
            R = __shfl(cum[0], r32);
        }
    }
    if (qb > 0) {
        bf16x8 ntri[2];
#pragma unroll
        for (int s = 0; s < 2; ++s)
#pragma unroll
            for (int jj = 0; jj < 8; ++jj) ntri[s][jj] = tri[s][jj] ? (short)0xBF80 : (short)0;
        const float cb = __builtin_amdgcn_exp2f(bias2);
        float Rb = R - bias2;
        const int kq0 = r32 * AT_KP + ((hh ^ (r32 & 1)) << 4), kshi = (r32 & 15) >> 1, vq0 = AT_KBYTES + r32 * AT_VP + ((hh ^ ((r32 >> 1) & 1)) << 4), vsw = (r32 >> 1) & 6;
        v4u wp0 = (v4u){0u, 0u, 0u, 0u}, wp1 = wp0;
        f32x16 z;
#pragma unroll
        for (int r = 0; r < 16; ++r) z[r] = 0.f;
        {   const LAS unsigned char* kb = L + ((qb - 1) & 3) * AT_BUF + 32 * AT_KP;
#pragma unroll
            for (int ks = 0; ks < 8; ++ks) { const bf16x8 kf = *(const LAS bf16x8*)(kb + kq0 + ((ks ^ kshi) << 5)); z = __builtin_amdgcn_mfma_f32_32x32x16_bf16(kf, qf[ks], z, 0, 0, 0); } }
        for (int T = qb - 1; T >= 0; --T) {
            asm volatile("s_waitcnt vmcnt(0)" ::: "memory");
            __syncthreads();
            if (T >= 2) AT_DMA(T - 2, (T - 2) & 3);
            const LAS unsigned char* s_hi = L + ((T + 1) & 3) * AT_BUF; const LAS unsigned char* s_cu = L + (T & 3) * AT_BUF; const LAS unsigned char* s_lo = L + ((T - 1) & 3) * AT_BUF;
            at_step<0>(s_cu, s_hi, kq0, kshi, vq0, vsw, qf, ntri, o, z, Rb, wp0, wp1, cb, r32);
            at_step<1>(s_lo + 32 * AT_KP, s_cu, kq0, kshi, vq0, vsw, qf, ntri, o, z, Rb, wp0, wp1, cb, r32);
        }
        {   const LAS unsigned char* vb = L;
#pragma unroll
            for (int i = 0; i < 8; ++i) { const bf16x8 vf = *(const LAS bf16x8*)(vb + vq0 + (i & 3) * 32 * AT_VP + (((2 * (i >> 2)) ^ vsw) << 4));
                o[i & 3] = __builtin_amdgcn_mfma_f32_32x32x16_bf16(vf, __builtin_bit_cast(bf16x8, i < 4 ? wp0 : wp1), o[i & 3], 0, 0, 0); } }
    }
#undef AT_DMA
    bf16* op = Ob + (size_t)t * DM + h * HD + 4 * hh;
#pragma unroll
    for (int db = 0; db < 4; ++db)
#pragma unroll
        for (int r4 = 0; r4 < 4; ++r4) { const unsigned long long pk = (unsigned long long)cvtpk(o[db][4 * r4 + 0], o[db][4 * r4 + 1]) | ((unsigned long long)cvtpk(o[db][4 * r4 + 2], o[db][4 * r4 + 3]) << 32);
            *(unsigned long long*)(op + 32 * db + 8 * r4) = pk; }
}
__device__ __forceinline__ void attn_prompt_phase(const Ctx& C) {
    KArgs A = kargs(); unsigned char* ws = A->ws; const float* sb_bias = INP(float, 23);
    const bf16* Kb = WSP(bf16, WS_KB); const bf16* Vt = WSP(bf16, WS_VT); const bf16* Qb = WSP(bf16, WS_QB); bf16* Ob = WSP(bf16, WS_OB);
    const int vcu = (C.G % 8 == 0) ? (C.bx % 8) * (C.G / 8) + C.bx / 8 : C.bx;
    for (int pi = vcu; pi < 256; pi += C.G) {
        const int kvh = pi >> 6, s = pi & 63;
        attn_prompt_unit(C, Qb, Kb, Vt, Ob, sb_bias, kvh, 127 - s);
        attn_prompt_unit(C, Qb, Kb, Vt, Ob, sb_bias, kvh, s);
    }
}


constexpr int SA_KP = 272, SA_VP = 80, SA_WAVE = 10240, SA_TS_OFF = 8 * SA_WAVE, SA_Q_OFF = SA_TS_OFF + 1024;
static_assert(32 * SA_KP <= SA_WAVE && 128 * SA_VP <= SA_WAVE && SA_Q_OFF + 32 * SA_KP <= RING_BYTES && 4 * 16384 <= SA_TS_OFF, "sample attention LDS");
__device__ __forceinline__ void attn_sample_unit(const Ctx& C, KArgs A, int b, int kvh) {
    unsigned char* ws = A->ws; float* out = A->out;
    const float* cache_k = INP(float, 6); const float* cache_v = INP(float, 7); const int* page_table = INP(int, 8); const float* sb_bias = INP(float, 23);
    const bf16* Qb = WSP(bf16, WS_QB); bf16* Ob = WSP(bf16, WS_OB);
    LAS unsigned char* const L = C.L; const int lane = C.lane, wave = C.wave;
    const int r32 = lane & 31, hh = lane >> 5, g = r32 >> 3, t = r32 & 7, h = kvh * 4 + g, row = TP + b * DECT + t;
    const int dl = lane & 31, par = lane >> 5;
    LAS unsigned char* const QT = L + SA_Q_OFF;
    { const int col = C.tid >> 4, ch = C.tid & 15; const v4u qv = *(const v4u*)(Qb + (size_t)(TP + b * DECT + (col & 7)) * DM + (kvh * 4 + (col >> 3)) * HD + ch * 8);
      *(LAS v4u*)(QT + col * SA_KP + ch * 16) = qv; }
    __syncthreads();
    const float bias2 = sb_bias[h] * LOG2E;
    bf16x8 tri[2];
#pragma unroll
    for (int s = 0; s < 2; ++s)
#pragma unroll
        for (int jj = 0; jj < 8; ++jj) { const int key = 16 * s + 8 * (jj >> 2) + 4 * hh + (jj & 3); tri[s][jj] = (key >= r32) ? (short)0x3F80 : (short)0; }
    f32x16 o[4];
#pragma unroll
    for (int db = 0; db < 4; ++db)
#pragma unroll
        for (int r = 0; r < 16; ++r) o[db][r] = 0.f;
    float R = 0.f;
    LAS unsigned char* const T = L + wave * SA_WAVE;
    f32x4 st[16];
    const int nblk = (wave == 7) ? 9 : 8;
#define SA_BASE(bi_, ptr_, cache_, newp_, isnew_) do { int kb_ = 7 - ((bi_) - (nblk - 8)); isnew_ = (kb_ > 7); if (isnew_) { ptr_ = (newp_) + ((size_t)b * DECT * NKV + kvh) * HD; } \
        else { const int pg_ = page_table[b * NPG + 2 * wave + (kb_ >> 2)]; ptr_ = (cache_) + (((size_t)pg_ * 128 + 32 * (kb_ & 3)) * NKV + kvh) * HD; } } while (0)
#define SA_UNI(p_) ((const char*)(uintptr_t)(((unsigned long long)(unsigned)__builtin_amdgcn_readfirstlane((int)((unsigned long long)(uintptr_t)(p_) >> 32)) << 32) | (unsigned)__builtin_amdgcn_readfirstlane((int)(unsigned)(unsigned long long)(uintptr_t)(p_))))
#define SA_LOADK(ptr_, isnew_) do { const char* ub_ = SA_UNI(ptr_); _Pragma("unroll") for (int q_ = 0; q_ < 16; ++q_) { \
        if (!(isnew_) || q_ < 4) st[q_] = __builtin_nontemporal_load((const f32x4*)(ub_ + q_ * 4096 + koff)); else st[q_] = (f32x4){0.f, 0.f, 0.f, 0.f}; } } while (0)
#define SA_LOADV(ptr_, isnew_) do { const char* ub_ = SA_UNI(ptr_); _Pragma("unroll") for (int q_ = 0; q_ < 16; ++q_) { \
        if (!(isnew_) || q_ < 4) st[q_] = __builtin_nontemporal_load((const f32x4*)(ub_ + (8 * (q_ >> 2) + (q_ & 3)) * 2048 + voff)); else st[q_] = (f32x4){0.f, 0.f, 0.f, 0.f}; } } while (0)
    const unsigned koff = (unsigned)(par * 2048 + dl * 16), voff = (unsigned)(par * 8192 + dl * 16);
    const float* kptr; const float* vptr; bool isnew;
    SA_BASE(0, kptr, cache_k, out + O_K_S, isnew);
    SA_LOADK(kptr, isnew);
    for (int bi = 0; bi < nblk; ++bi) {
#pragma unroll
        for (int q = 0; q < 16; ++q) { const unsigned long long pk = (unsigned long long)cvtpk(st[q].x, st[q].y) | ((unsigned long long)cvtpk(st[q].z, st[q].w) << 32);
            *(LAS unsigned long long*)(T + (2 * q + par) * SA_KP + dl * 8) = pk; }
        SA_BASE(bi, vptr, cache_v, out + O_V_S, isnew);
        SA_LOADV(vptr, isnew);
        f32x16 z;
#pragma unroll
        for (int r = 0; r < 16; ++r) z[r] = bias2;
#pragma unroll
        for (int ks = 0; ks < 8; ++ks) { const bf16x8 kf = *(const LAS bf16x8*)(T + r32 * SA_KP + (16 * ks + 8 * hh) * 2); const bf16x8 qq = *(const LAS bf16x8*)(QT + r32 * SA_KP + (16 * ks + 8 * hh) * 2); z = __builtin_amdgcn_mfma_f32_32x32x16_bf16(kf, qq, z, 0, 0, 0); }
        if (isnew) {
#pragma unroll
            for (int r = 0; r < 16; ++r) { const int kk = (r & 3) + 8 * (r >> 2) + 4 * hh; if (kk >= t) z[r] = -INFINITY; } }
        f32x16 sp;
#pragma unroll
        for (int r = 0; r < 16; ++r) sp[r] = __builtin_amdgcn_logf(1.f + __builtin_amdgcn_exp2f(z[r]));
        const bf16x8 sp0 = pack8(sp, 0), sp1 = pack8(sp, 1);
        f32x16 cum;
#pragma unroll
        for (int r = 0; r < 16; ++r) cum[r] = R;
        cum = __builtin_amdgcn_mfma_f32_32x32x16_bf16(tri[0], sp0, cum, 0, 0, 0);
        cum = __builtin_amdgcn_mfma_f32_32x32x16_bf16(tri[1], sp1, cum, 0, 0, 0);
#pragma unroll
        for (int r = 0; r < 16; ++r) sp[r] = __builtin_amdgcn_exp2f(z[r] - cum[r]);
        const bf16x8 w0 = pack8(sp, 0), w1 = pack8(sp, 1);
#pragma unroll
        for (int q4 = 0; q4 < 4; ++q4)
#pragma unroll
            for (int e = 0; e < 4; ++e) { const unsigned long long pk = (unsigned long long)cvtpk(st[q4 * 4 + 0][e], st[q4 * 4 + 1][e]) | ((unsigned long long)cvtpk(st[q4 * 4 + 2][e], st[q4 * 4 + 3][e]) << 32);
                *(LAS unsigned long long*)(T + (4 * dl + e) * SA_VP + (16 * (q4 >> 1) + 8 * par + 4 * (q4 & 1)) * 2) = pk; }
        if (bi + 1 < nblk) { SA_BASE(bi + 1, kptr, cache_k, out + O_K_S, isnew); SA_LOADK(kptr, isnew); }
#pragma unroll
        for (int db = 0; db < 4; ++db) {
            const bf16x8 v0 = *(const LAS bf16x8*)(T + (32 * db + r32) * SA_VP + (8 * hh) * 2);
            const bf16x8 v1 = *(const LAS bf16x8*)(T + (32 * db + r32) * SA_VP + (16 + 8 * hh) * 2);
            o[db] = __builtin_amdgcn_mfma_f32_32x32x16_bf16(v0, w0, o[db], 0, 0, 0);
            o[db] = __builtin_amdgcn_mfma_f32_32x32x16_bf16(v1, w1, o[db], 0, 0, 0); }
        R = __shfl(cum[0], r32);
    }
#undef SA_BASE
#undef SA_LOADK
#undef SA_LOADV
#undef SA_UNI
    LAS float* TS = (LAS float*)(L + SA_TS_OFF);
    if (hh == 0) TS[wave * 32 + r32] = R;
    __syncthreads();
    float later = 0.f;
    for (int w2 = wave + 1; w2 < 8; ++w2) later += TS[w2 * 32 + r32];
    const float fsc = __builtin_amdgcn_exp2f(-later);
#pragma unroll
    for (int db = 0; db < 4; ++db)
#pragma unroll
        for (int r = 0; r < 16; ++r) o[db][r] *= fsc;
#pragma unroll
    for (int rd = 0; rd < 3; ++rd) { const int half = 4 >> rd;
        if (wave >= half && wave < 2 * half) { LAS float* S = (LAS float*)(L + (wave - half) * 16384);
#pragma unroll
            for (int db = 0; db < 4; ++db)
#pragma unroll
                for (int r = 0; r < 16; ++r) S[(db * 16 + r) * 64 + lane] = o[db][r]; }
        __syncthreads();
        if (wave < half) { const LAS float* S = (const LAS float*)(L + wave * 16384);
#pragma unroll
            for (int db = 0; db < 4; ++db)
#pragma unroll
                for (int r = 0; r < 16; ++r) o[db][r] += S[(db * 16 + r) * 64 + lane]; }
        __syncthreads();
    }
    if (wave == 0) { bf16* op = Ob + (size_t)row * DM + h * HD + 4 * hh;
#pragma unroll
        for (int db = 0; db < 4; ++db)
#pragma unroll
            for (int r4 = 0; r4 < 4; ++r4) { const unsigned long long pk = (unsigned long long)cvtpk(o[db][4 * r4 + 0], o[db][4 * r4 + 1]) | ((unsigned long long)cvtpk(o[db][4 * r4 + 2], o[db][4 * r4 + 3]) << 32);
                *(unsigned long long*)(op + 32 * db + 8 * r4) = pk; } }
}
constexpr int SB_PAIR = 20480, SB_VOFF = 10240;
static_assert(32 * SA_KP <= SB_VOFF && SB_VOFF + 128 * SA_VP <= SB_PAIR && 4 * SB_PAIR <= SA_TS_OFF, "specialised sample attention LDS");
#define SB_POLL(flag_, need_) do { unsigned sp_ = 0u; while ((unsigned)__builtin_amdgcn_readfirstlane((int)*(flag_)) < (unsigned)(need_)) { __builtin_amdgcn_s_sleep(1); if (++sp_ > (1u << 22)) break; } asm volatile("" ::: "memory"); } while (0)
__device__ __forceinline__ void attn_sample_unit2(const Ctx& C, KArgs A, int b, int kvh) {
    unsigned char* ws = A->ws; float* out = A->out;
    const float* cache_k = INP(float, 6); const float* cache_v = INP(float, 7); const int* page_table = INP(int, 8); const float* sb_bias = INP(float, 23);
    const bf16* Qb = WSP(bf16, WS_QB); bf16* Ob = WSP(bf16, WS_OB);
    LAS unsigned char* const L = C.L; int lane = C.lane, tid = C.tid; const int wave = C.wave;
    asm volatile("" : "+v"(lane), "+v"(tid));
    const int r32 = lane & 31, hh = lane >> 5, g = r32 >> 3, t = r32 & 7, h = kvh * 4 + g, row = TP + b * DECT + t;
    const int dl = lane & 31, par = lane >> 5;
    const int pw = wave & 3;
    LAS unsigned char* const QT = L + SA_Q_OFF;
    volatile LAS unsigned* const FL = (volatile LAS unsigned*)(L + MISC_OFF) + 32 + 4 * pw;
    { const int col = tid >> 4, ch = tid & 15; const v4u qv = *(const v4u*)(Qb + (size_t)(TP + b * DECT + (col & 7)) * DM + (kvh * 4 + (col >> 3)) * HD + ch * 8);
      *(LAS v4u*)(QT + col * SA_KP + ch * 16) = qv; }
    if (tid < 16) ((volatile LAS unsigned*)(L + MISC_OFF) + 32)[tid] = 0u;
    __syncthreads();
    LAS unsigned char* const TK = L + pw * SB_PAIR; LAS unsigned char* const TV = TK + SB_VOFF;
    const int nblk = (pw == 3) ? 17 : 16;
    if (wave >= 4) {
        f32x4 sA[8], sB[8], sC[8], sD[8], sE[8];
        int pgs[4];
#pragma unroll
        for (int k_ = 0; k_ < 4; ++k_) pgs[k_] = __builtin_amdgcn_readfirstlane(page_table[b * NPG + 4 * pw + k_]);
        const unsigned koff = (unsigned)(par * 2048 + dl * 16), voff = (unsigned)(par * 8192 + dl * 16);
#define SB_UNI(p_) ((const char*)(uintptr_t)(((unsigned long long)(unsigned)__builtin_amdgcn_readfirstlane((int)((unsigned long long)(uintptr_t)(p_) >> 32)) << 32) | (unsigned)__builtin_amdgcn_readfirstlane((int)(unsigned)(unsigned long long)(uintptr_t)(p_))))
#define SB_ISSUE(st_, t_) do { constexpr int bi_ = (t_) >> 2, KIND_ = ((t_) >> 1) & 1, hf_ = (t_) & 1; const int kb_ = 15 - (bi_ - (nblk - 16)); const bool nw_ = (bi_ == 0) && (kb_ > 15); const float* p_; \
        if (nw_) p_ = (KIND_ ? out + O_V_S : out + O_K_S) + ((size_t)b * DECT * NKV + kvh) * HD; \
        else { const int pg_ = (nblk == 17) ? pgs[((16 - bi_) & 15) >> 2] : pgs[((15 - bi_) & 15) >> 2]; p_ = (KIND_ ? cache_v : cache_k) + (((size_t)pg_ * 128 + 32 * (kb_ & 3)) * NKV + kvh) * HD; } \
        const __amdgpu_buffer_rsrc_t rs_ = __builtin_amdgcn_make_buffer_rsrc((void*)SB_UNI(p_), (short)0, 0x7fffffff, 0x00020000); const int qm_ = nw_ ? 3 : 15; \
        _Pragma("unroll") for (int q_ = 0; q_ < 8; ++q_) { const int qq_ = (q_ + 8 * hf_) & qm_; \
            st_[q_] = __builtin_bit_cast(f32x4, __builtin_amdgcn_raw_buffer_load_b128(rs_, (int)(KIND_ ? voff : koff), KIND_ ? (8 * (qq_ >> 2) + (qq_ & 3)) * 2048 : qq_ * 4096, 2)); } } while (0)
#define SB_EMIT(st_, t_) do { constexpr int bi_ = (t_) >> 2, KIND_ = ((t_) >> 1) & 1, hf_ = (t_) & 1; \
        if (bi_ == 0) { if (nblk == 17) { _Pragma("unroll") for (int q_ = 0; q_ < 8; ++q_) if (q_ + 8 * hf_ >= 4) st_[q_] = (f32x4){0.f, 0.f, 0.f, 0.f}; } } \
        if (KIND_) { if (hf_ == 0) SB_POLL(FL + 3, bi_); \
            _Pragma("unroll") for (int q4_ = 0; q4_ < 2; ++q4_) _Pragma("unroll") for (int e_ = 0; e_ < 4; ++e_) { \
                const unsigned long long pk_ = (unsigned long long)cvtpk(st_[q4_ * 4 + 0][e_], st_[q4_ * 4 + 1][e_]) | ((unsigned long long)cvtpk(st_[q4_ * 4 + 2][e_], st_[q4_ * 4 + 3][e_]) << 32); \
                *(LAS unsigned long long*)(TV + (4 * dl + e_) * SA_VP + (16 * hf_ + 8 * par + 4 * q4_) * 2) = pk_; } \
            asm volatile("" ::: "memory"); FL[2] = (unsigned)(2 * bi_ + hf_ + 1); } \
        else { if (hf_ == 0) SB_POLL(FL + 1, bi_); \
            _Pragma("unroll") for (int q_ = 0; q_ < 8; ++q_) { const unsigned long long pk_ = (unsigned long long)cvtpk(st_[q_].x, st_[q_].y) | ((unsigned long long)cvtpk(st_[q_].z, st_[q_].w) << 32); \
                *(LAS unsigned long long*)(TK + (2 * (q_ + 8 * hf_) + par) * SA_KP + dl * 8) = pk_; } \
            asm volatile("" ::: "memory"); FL[0] = (unsigned)(2 * bi_ + hf_ + 1); } } while (0)
#define SB_E(st_, t_) SB_EMIT(st_, t_)
#define SB_I(st_, t_) SB_ISSUE(st_, t_)
        SB_I(sA, 0); SB_I(sB, 1); SB_I(sC, 2); SB_I(sD, 3); SB_I(sE, 4);
        SB_E(sA, 0); SB_I(sA, 5);
        SB_E(sB, 1); SB_I(sB, 6);
        SB_E(sC, 2); SB_I(sC, 7);
        SB_E(sD, 3); SB_I(sD, 8);
        SB_E(sE, 4); SB_I(sE, 9);
        SB_E(sA, 5); SB_I(sA, 10);
        SB_E(sB, 6); SB_I(sB, 11);
        SB_E(sC, 7); SB_I(sC, 12);
        SB_E(sD, 8); SB_I(sD, 13);
        SB_E(sE, 9); SB_I(sE, 14);
        SB_E(sA, 10); SB_I(sA, 15);
        SB_E(sB, 11); SB_I(sB, 16);
        SB_E(sC, 12); SB_I(sC, 17);
        SB_E(sD, 13); SB_I(sD, 18);
        SB_E(sE, 14); SB_I(sE, 19);
        SB_E(sA, 15); SB_I(sA, 20);
        SB_E(sB, 16); SB_I(sB, 21);
        SB_E(sC, 17); SB_I(sC, 22);
        SB_E(sD, 18); SB_I(sD, 23);
        SB_E(sE, 19); SB_I(sE, 24);
        SB_E(sA, 20); SB_I(sA, 25);
        SB_E(sB, 21); SB_I(sB, 26);
        SB_E(sC, 22); SB_I(sC, 27);
        SB_E(sD, 23); SB_I(sD, 28);
        SB_E(sE, 24); SB_I(sE, 29);
        SB_E(sA, 25); SB_I(sA, 30);
        SB_E(sB, 26); SB_I(sB, 31);
        SB_E(sC, 27); SB_I(sC, 32);
        SB_E(sD, 28); SB_I(sD, 33);
        SB_E(sE, 29); SB_I(sE, 34);
        SB_E(sA, 30); SB_I(sA, 35);
        SB_E(sB, 31); SB_I(sB, 36);
        SB_E(sC, 32); SB_I(sC, 37);
        SB_E(sD, 33); SB_I(sD, 38);
        SB_E(sE, 34); SB_I(sE, 39);
        SB_E(sA, 35); SB_I(sA, 40);
        SB_E(sB, 36); SB_I(sB, 41);
        SB_E(sC, 37); SB_I(sC, 42);
        SB_E(sD, 38); SB_I(sD, 43);
        SB_E(sE, 39); SB_I(sE, 44);
        SB_E(sA, 40); SB_I(sA, 45);
        SB_E(sB, 41); SB_I(sB, 46);
        SB_E(sC, 42); SB_I(sC, 47);
        SB_E(sD, 43); SB_I(sD, 48);
        SB_E(sE, 44); SB_I(sE, 49);
        SB_E(sA, 45); SB_I(sA, 50);
        SB_E(sB, 46); SB_I(sB, 51);
        SB_E(sC, 47); SB_I(sC, 52);
        SB_E(sD, 48); SB_I(sD, 53);
        SB_E(sE, 49); SB_I(sE, 54);
        SB_E(sA, 50); SB_I(sA, 55);
        SB_E(sB, 51); SB_I(sB, 56);
        SB_E(sC, 52); SB_I(sC, 57);
        SB_E(sD, 53); SB_I(sD, 58);
        SB_E(sE, 54); SB_I(sE, 59);
        SB_E(sA, 55); SB_I(sA, 60);
        SB_E(sB, 56); SB_I(sB, 61);
        SB_E(sC, 57); SB_I(sC, 62);
        SB_E(sD, 58); SB_I(sD, 63);
        SB_E(sE, 59); if (pw == 3) { SB_I(sE, 64); }
        SB_E(sA, 60); if (pw == 3) { SB_I(sA, 65); }
        SB_E(sB, 61); if (pw == 3) { SB_I(sB, 66); }
        SB_E(sC, 62); if (pw == 3) { SB_I(sC, 67); }
        SB_E(sD, 63);
        if (pw == 3) { SB_E(sE, 64); }
        if (pw == 3) { SB_E(sA, 65); }
        if (pw == 3) { SB_E(sB, 66); }
        if (pw == 3) { SB_E(sC, 67); }
#undef SB_E
#undef SB_I
#undef SB_UNI
#undef SB_ISSUE
#undef SB_EMIT
        __syncthreads(); __syncthreads(); __syncthreads(); __syncthreads(); __syncthreads(); __syncthreads();
    } else {
        f32x16 o[4];
#pragma unroll
        for (int db = 0; db < 4; ++db)
#pragma unroll
            for (int r = 0; r < 16; ++r) o[db][r] = 0.f;
        float R = 0.f;
        const float bias2 = sb_bias[h] * LOG2E;
        bf16x8 tri[2];
#pragma unroll
        for (int s_ = 0; s_ < 2; ++s_)
#pragma unroll
            for (int jj = 0; jj < 8; ++jj) { const int key = 16 * s_ + 8 * (jj >> 2) + 4 * hh + (jj & 3); tri[s_][jj] = (key >= r32) ? (short)0x3F80 : (short)0; }
        for (int bi = 0; bi < nblk; ++bi) {
            const bool isnew = (pw == 3) && (bi == 0);
            SB_POLL(FL + 0, 2 * (bi + 1));
            bf16x8 kf[8];
#pragma unroll
            for (int ks = 0; ks < 8; ++ks) kf[ks] = *(const LAS bf16x8*)(TK + r32 * SA_KP + (16 * ks + 8 * hh) * 2);
            asm volatile("s_waitcnt lgkmcnt(0)" ::: "memory");
            FL[1] = (unsigned)(bi + 1);
            f32x16 z;
#pragma unroll
            for (int r = 0; r < 16; ++r) z[r] = bias2;
#pragma unroll
            for (int ks = 0; ks < 8; ++ks) { const bf16x8 qq = *(const LAS bf16x8*)(QT + r32 * SA_KP + (16 * ks + 8 * hh) * 2); z = __builtin_amdgcn_mfma_f32_32x32x16_bf16(kf[ks], qq, z, 0, 0, 0); }
            if (isnew) {
#pragma unroll
                for (int r = 0; r < 16; ++r) { const int kk = (r & 3) + 8 * (r >> 2) + 4 * hh; if (kk >= t) z[r] = -INFINITY; } }
            f32x16 sp;
#pragma unroll
            for (int r = 0; r < 16; ++r) sp[r] = __builtin_amdgcn_logf(1.f + __builtin_amdgcn_exp2f(z[r]));
            const bf16x8 sp0 = pack8(sp, 0), sp1 = pack8(sp, 1);
            f32x16 cum;
#pragma unroll
            for (int r = 0; r < 16; ++r) cum[r] = R;
            cum = __builtin_amdgcn_mfma_f32_32x32x16_bf16(tri[0], sp0, cum, 0, 0, 0);
            cum = __builtin_amdgcn_mfma_f32_32x32x16_bf16(tri[1], sp1, cum, 0, 0, 0);
#pragma unroll
            for (int r = 0; r < 16; ++r) sp[r] = __builtin_amdgcn_exp2f(z[r] - cum[r]);
            const bf16x8 w0 = pack8(sp, 0), w1 = pack8(sp, 1);
            SB_POLL(FL + 2, 2 * (bi + 1));
#pragma unroll
            for (int db = 0; db < 4; ++db) {
                const bf16x8 v0 = *(const LAS bf16x8*)(TV + (32 * db + r32) * SA_VP + (8 * hh) * 2);
                const bf16x8 v1 = *(const LAS bf16x8*)(TV + (32 * db + r32) * SA_VP + (16 + 8 * hh) * 2);
                o[db] = __builtin_amdgcn_mfma_f32_32x32x16_bf16(v0, w0, o[db], 0, 0, 0);
                o[db] = __builtin_amdgcn_mfma_f32_32x32x16_bf16(v1, w1, o[db], 0, 0, 0); }
            asm volatile("s_waitcnt lgkmcnt(0)" ::: "memory");
            FL[3] = (unsigned)(bi + 1);
            R = __shfl(cum[0], r32);
        }
    LAS float* TS = (LAS float*)(L + SA_TS_OFF);
    __syncthreads();
    if (hh == 0) TS[wave * 32 + r32] = R;
    __syncthreads();
    {
        float later = 0.f;
        for (int w2 = wave + 1; w2 < 4; ++w2) later += TS[w2 * 32 + r32];
        const float fsc = __builtin_amdgcn_exp2f(-later);
#pragma unroll
        for (int db = 0; db < 4; ++db)
#pragma unroll
            for (int r = 0; r < 16; ++r) o[db][r] *= fsc;
    }
#pragma unroll
    for (int rd = 0; rd < 2; ++rd) { const int half = 2 >> rd;
        if (wave >= half && wave < 2 * half) { LAS float* S = (LAS float*)(L + (wave - half) * 16384);
#pragma unroll
            for (int db = 0; db < 4; ++db)
#pragma unroll
                for (int r = 0; r < 16; ++r) S[(db * 16 + r) * 64 + lane] = o[db][r]; }
        __syncthreads();
        if (wave < half) { const LAS float* S = (const LAS float*)(L + wave * 16384);
#pragma unroll
            for (int db = 0; db < 4; ++db)
#pragma unroll
                for (int r = 0; r < 16; ++r) o[db][r] += S[(db * 16 + r) * 64 + lane]; }
        __syncthreads();
    }
    if (wave == 0) { bf16* op = Ob + (size_t)row * DM + h * HD + 4 * hh;
#pragma unroll
        for (int db = 0; db < 4; ++db)
#pragma unroll
            for (int r4 = 0; r4 < 4; ++r4) { const unsigned long long pk = (unsigned long long)cvtpk(o[db][4 * r4 + 0], o[db][4 * r4 + 1]) | ((unsigned long long)cvtpk(o[db][4 * r4 + 2], o[db][4 * r4 + 3]) << 32);
                *(unsigned long long*)(op + 32 * db + 8 * r4) = pk; } }
    }
}
__device__ __forceinline__ void attn_sample_phase(const Ctx& C) {
    KArgs A = kargs();
    const int vcu = (C.G % 8 == 0) ? (C.bx % 8) * (C.G / 8) + C.bx / 8 : C.bx;
    for (int u = vcu; u < DECB * NKV; u += C.G) attn_sample_unit(C, A, u >> 2, u & 3);
}


__device__ __forceinline__ void attn_drain_sample(const Ctx& C) {
    KArgs A = kargs(); unsigned char* ws = A->ws;
    unsigned* head_s = (unsigned*)(ws + WS_CTL) + CW_ATQ + 64 * 4;
    volatile LAS unsigned* slot = (volatile LAS unsigned*)(C.L + MISC_OFF) + 16;
    for (;;) {
        __syncthreads();
        if (C.tid == 0) *slot = __hip_atomic_fetch_add(head_s, 1u, __ATOMIC_RELAXED, __HIP_MEMORY_SCOPE_AGENT);
        __syncthreads();
        const unsigned idx = *slot;
        if (idx >= (unsigned)(DECB * NKV)) break;
        attn_sample_unit2(C, A, (int)(idx >> 2), (int)(idx & 3));
    }
}
__device__ __forceinline__ void attn_drain_prompt(const Ctx& C) {
    KArgs A = kargs(); unsigned char* ws = A->ws; const float* sb_bias = INP(float, 23);
    const bf16* Kb = WSP(bf16, WS_KB); const bf16* Vt = WSP(bf16, WS_VT); const bf16* Qb = WSP(bf16, WS_QB); bf16* Ob = WSP(bf16, WS_OB);
    const int g = (C.bx & 7) >> 1;
    unsigned* head_p = (unsigned*)(ws + WS_CTL) + CW_ATQ + 64 * g;
    volatile LAS unsigned* slot = (volatile LAS unsigned*)(C.L + MISC_OFF) + 16;
    for (;;) {
        __syncthreads();
        if (C.tid == 0) *slot = __hip_atomic_fetch_add(head_p, 1u, __ATOMIC_RELAXED, __HIP_MEMORY_SCOPE_AGENT);
        __syncthreads();
        const unsigned idx = *slot;
        if (idx >= 128u) break;
        attn_prompt_unit(C, Qb, Kb, Vt, Ob, sb_bias, g, 127 - (int)idx);
    }
}
__device__ __forceinline__ void attn_phase_dealt(const Ctx& C) {
    if ((C.bx >> 3) >= AT_SMP_R0) { attn_drain_sample(C); attn_drain_prompt(C); } else { attn_drain_prompt(C); attn_drain_sample(C); }
}


constexpr int SG_P = 272, SG_ABYTES = 128 * SG_P, SG_BBYTES = 64 * SG_P, SG_BUF = SG_ABYTES + SG_BBYTES;
static_assert(2 * SG_BUF <= RING_BYTES, "small GEMM LDS");
struct SEmitGate { static constexpr bool NEEDS = false, STATS = false; const bf16* Gm; bf16* O; const float* stp; float* stn; __device__ __forceinline__ f32x4 operator()(int row, int col, f32x4 v, float, float) const { const size_t o = (size_t)row * DM + col; const unsigned long long gq = *(const unsigned long long*)(Gm + o); const unsigned g0 = (unsigned)gq, g1 = (unsigned)(gq >> 32);
    *(unsigned long long*)(O + o) = (unsigned long long)cvtpk(bflo(g0) * pg8::sigm(v[0]), bfhi(g0) * pg8::sigm(v[1])) | ((unsigned long long)cvtpk(bflo(g1) * pg8::sigm(v[2]), bfhi(g1) * pg8::sigm(v[3])) << 32); return v; } };
template <int ACT> struct SEmitAct { static constexpr bool NEEDS = (ACT == 1), STATS = false; bf16* O; int ldc; const float* stp; const float* c1; const float* c2; float* stn; __device__ __forceinline__ f32x4 operator()(int row, int col, f32x4 v, float mu, float rstd) const {
    if (ACT == 1) { const f32x4 a4 = *(const f32x4*)(c1 + col), d4 = *(const f32x4*)(c2 + col); v = (v - a4 * mu) * rstd + d4;
#pragma unroll
        for (int i = 0; i < 4; ++i) { const float a = fmaxf(v[i], 0.f); v[i] = a * a; } }
    *(unsigned long long*)(O + (size_t)row * ldc + col) = (unsigned long long)cvtpk(v[0], v[1]) | ((unsigned long long)cvtpk(v[2], v[3]) << 32); return v; } };
struct SEmitRes { static constexpr bool NEEDS = true, STATS = true; const float* X; const bf16* Xb; const float* stp; const float* gp; const float* bp; float* R; bf16* Rb; float* stn; __device__ __forceinline__ f32x4 operator()(int row, int col, f32x4 v, float mu, float rstd) const { const size_t o = (size_t)row * DM + col; f32x4 x;
    if (stp) { const unsigned long long xq = *(const unsigned long long*)(Xb + o); const unsigned x0 = (unsigned)xq, x1 = (unsigned)(xq >> 32); x = (f32x4){bflo(x0), bfhi(x0), bflo(x1), bfhi(x1)}; const f32x4 g4 = *(const f32x4*)(gp + col), b4 = *(const f32x4*)(bp + col); x = (x - mu) * rstd * g4 + b4; } else x = *(const f32x4*)(X + o);
    const f32x4 r = x * DN_ALPHA + v; if (R) *(f32x4*)(R + o) = r; *(unsigned long long*)(Rb + o) = (unsigned long long)cvtpk(r[0], r[1]) | ((unsigned long long)cvtpk(r[2], r[3]) << 32); return r; } };
struct SEmitPle { static constexpr bool NEEDS = true, STATS = true; const bf16* X; const bf16* E; const float* stp; const float* gp; const float* bp; const float* c1; const float* c2; float* R; bf16* Rb; float* stn; __device__ __forceinline__ f32x4 operator()(int row, int col, f32x4 acc, float mu, float rstd) const { const size_t o = (size_t)row * DM + col; const unsigned long long xq = *(const unsigned long long*)(X + o); const unsigned x0 = (unsigned)xq, x1 = (unsigned)(xq >> 32); f32x4 x = {bflo(x0), bfhi(x0), bflo(x1), bfhi(x1)};
    const f32x4 g4 = *(const f32x4*)(gp + col), b4 = *(const f32x4*)(bp + col), a4 = *(const f32x4*)(c1 + col), d4 = *(const f32x4*)(c2 + col);
    x = (x - mu) * rstd * g4 + b4; const f32x4 v = (acc - a4 * mu) * rstd + d4;
    const unsigned long long eq = *(const unsigned long long*)(E + o); const unsigned e0 = (unsigned)eq, e1 = (unsigned)(eq >> 32);
    f32x4 r; r[0] = x[0] * DN_ALPHA + bflo(e0) * pg8::sigm(v[0]); r[1] = x[1] * DN_ALPHA + bfhi(e0) * pg8::sigm(v[1]); r[2] = x[2] * DN_ALPHA + bflo(e1) * pg8::sigm(v[2]); r[3] = x[3] * DN_ALPHA + bfhi(e1) * pg8::sigm(v[3]);
    if (R) *(f32x4*)(R + o) = r; if (Rb) *(unsigned long long*)(Rb + o) = (unsigned long long)cvtpk(r[0], r[1]) | ((unsigned long long)cvtpk(r[2], r[3]) << 32); return r; } };
struct SEmitKVQ { static constexpr bool NEEDS = true, STATS = false; float* ks; float* vs; bf16* Qb; const float* stp; const float* c1; const float* c2; float* stn; __device__ __forceinline__ f32x4 operator()(int row, int col, f32x4 acc, float mu, float rstd) const {
    const f32x4 a4 = *(const f32x4*)(c1 + col), d4 = *(const f32x4*)(c2 + col); const f32x4 v = (acc - a4 * mu) * rstd + d4;
    if (col < 512) *(f32x4*)(ks + (size_t)(row - TP) * 512 + col) = v;
    else if (col < 1024) *(f32x4*)(vs + (size_t)(row - TP) * 512 + (col - 512)) = v;
    else { const f32x4 q = v * QSCALE; *(unsigned long long*)(Qb + (size_t)row * DM + (col - 1024)) = (unsigned long long)cvtpk(q[0], q[1]) | ((unsigned long long)cvtpk(q[2], q[3]) << 32); } return v; } };
template <class Emit> __device__ __forceinline__ void small_gemm(const Ctx& C, const bf16* Ag, const bf16* Bt, int N, int K, int first, int stride, const Emit& E) {
    LAS unsigned char* const L = C.L; const int tid = C.tid, lane = C.lane, wave = C.wave;
    const int r32 = lane & 31, hh = lane >> 5, wm = wave >> 1, wn = wave & 1;
    const int nN = N / 64, nunits = (NSMP / 128) * nN, nkt = K / 128;
    const int prow = tid >> 4, pch = tid & 15;
    for (int u = first; u < nunits; u += stride) {
        const int mt = u / nN, nt = u - mt * nN; const int row0 = TP + mt * 128, n0 = nt * 64;
        const bf16* ag = Ag + (size_t)(row0 + prow) * K + pch * 8; const bf16* bg = Bt + (size_t)(n0 + prow) * K + pch * 8;
        v4u sa0[4], sb0[2], sa1[4], sb1[2];
#define SG_LOAD(sa_, sb_, kt_) do { _Pragma("unroll") for (int i_ = 0; i_ < 4; ++i_) sa_[i_] = *(const v4u*)(ag + (size_t)(32 * i_) * K + (kt_) * 128); \
        _Pragma("unroll") for (int i_ = 0; i_ < 2; ++i_) sb_[i_] = *(const v4u*)(bg + (size_t)(32 * i_) * K + (kt_) * 128); } while (0)
#define SG_STORE(buf_, sa_, sb_) do { LAS unsigned char* B_ = L + (buf_) * SG_BUF; _Pragma("unroll") for (int i_ = 0; i_ < 4; ++i_) *(LAS v4u*)(B_ + (prow + 32 * i_) * SG_P + pch * 16) = sa_[i_]; \
        _Pragma("unroll") for (int i_ = 0; i_ < 2; ++i_) *(LAS v4u*)(B_ + SG_ABYTES + (prow + 32 * i_) * SG_P + pch * 16) = sb_[i_]; } while (0)
#define SG_SYNC() do { asm volatile("s_waitcnt lgkmcnt(0)" ::: "memory"); __builtin_amdgcn_s_barrier(); asm volatile("" ::: "memory"); } while (0)
#define SG_MMA(buf_) do { const LAS unsigned char* AB_ = L + (buf_) * SG_BUF + (32 * wm + r32) * SG_P + 16 * hh; const LAS unsigned char* BB_ = L + (buf_) * SG_BUF + SG_ABYTES + (32 * wn + r32) * SG_P + 16 * hh; \
        _Pragma("unroll") for (int ks = 0; ks < 8; ++ks) { const bf16x8 wf = *(const LAS bf16x8*)(BB_ + 32 * ks); const bf16x8 af = *(const LAS bf16x8*)(AB_ + 32 * ks); acc = __builtin_amdgcn_mfma_f32_32x32x16_bf16(wf, af, acc, 0, 0, 0); } } while (0)
        f32x16 acc;
#pragma unroll
        for (int r = 0; r < 16; ++r) acc[r] = 0.f;
        SG_LOAD(sa0, sb0, 0); SG_LOAD(sa1, sb1, 1);
        SG_STORE(0, sa0, sb0); if (nkt > 2) SG_LOAD(sa0, sb0, 2); SG_SYNC();
        for (int kt = 0; kt < nkt; kt += 2) {
            SG_STORE(1, sa1, sb1);
            if (kt + 3 < nkt) SG_LOAD(sa1, sb1, kt + 3);
            SG_MMA(0);
            SG_SYNC();
            if (kt + 2 < nkt) SG_STORE(0, sa0, sb0);
            if (kt + 4 < nkt) SG_LOAD(sa0, sb0, kt + 4);
            SG_MMA(1);
            SG_SYNC();
        }
#undef SG_LOAD
#undef SG_STORE
#undef SG_SYNC
#undef SG_MMA
        const int row = row0 + 32 * wm + r32;
        float mu_ = 0.f, rstd_ = 1.f, ss_ = 0.f, qq_ = 0.f;
        if (Emit::NEEDS) { if (E.stp) { const pg8::f32x2e ms = pg8::stat_get(E.stp, row); mu_ = ms.x; rstd_ = ms.y; } }
#pragma unroll
        for (int r4 = 0; r4 < 4; ++r4) { const f32x4 v = {acc[4 * r4 + 0], acc[4 * r4 + 1], acc[4 * r4 + 2], acc[4 * r4 + 3]}; const f32x4 r = E(row, n0 + 32 * wn + 8 * r4 + 4 * hh, v, mu_, rstd_);
            if (Emit::STATS) { ss_ += (r[0] + r[1]) + (r[2] + r[3]); qq_ += (r[0] * r[0] + r[1] * r[1]) + (r[2] * r[2] + r[3] * r[3]); } }
        if (Emit::STATS) { ss_ += __shfl_xor(ss_, 32); qq_ += __shfl_xor(qq_, 32); atomicAdd(E.stn + 2 * (size_t)row + hh, hh ? qq_ : ss_); }
    }
}


constexpr int SW_P = 144, SW_ABYTES = 128 * SW_P, SW_BBYTES = 256 * SW_P, SW_BUF = SW_ABYTES + SW_BBYTES;
static_assert(2 * SW_BUF <= RING_BYTES, "wide small GEMM LDS");
template <class Emit> __device__ __forceinline__ void small_gemm_wide(const Ctx& C, const bf16* Ag, const bf16* Bt, int N, int K, int first, int stride, const Emit& E) {
    LAS unsigned char* const L = C.L; const int tid = C.tid, lane = C.lane, wave = C.wave;
    const int r32 = lane & 31, hh = lane >> 5, wm = wave >> 2, wn = wave & 3;
    const int nN = N / 256, nunits = (NSMP / 128) * nN, nkt = K / 64;
    const int prow = tid >> 3, pch = tid & 7;
    for (int u = first; u < nunits; u += stride) {
        const int mt = u / nN, nt = u - mt * nN; const int row0 = TP + mt * 128, n0 = nt * 256;
        const bf16* ag = Ag + (size_t)(row0 + prow) * K + pch * 8; const bf16* bg = Bt + (size_t)(n0 + prow) * K + pch * 8;
        v4u sa0[2], sb0[4], sa1[2], sb1[4];
#define SW_LOAD(sa_, sb_, kt_) do { _Pragma("unroll") for (int i_ = 0; i_ < 2; ++i_) sa_[i_] = *(const v4u*)(ag + (size_t)(64 * i_) * K + (kt_) * 64); \
        _Pragma("unroll") for (int i_ = 0; i_ < 4; ++i_) sb_[i_] = *(const v4u*)(bg + (size_t)(64 * i_) * K + (kt_) * 64); } while (0)
#define SW_STORE(buf_, sa_, sb_) do { LAS unsigned char* B_ = L + (buf_) * SW_BUF; _Pragma("unroll") for (int i_ = 0; i_ < 2; ++i_) *(LAS v4u*)(B_ + (prow + 64 * i_) * SW_P + pch * 16) = sa_[i_]; \
        _Pragma("unroll") for (int i_ = 0; i_ < 4; ++i_) *(LAS v4u*)(B_ + SW_ABYTES + (prow + 64 * i_) * SW_P + pch * 16) = sb_[i_]; } while (0)
#define SW_SYNC() do { asm volatile("s_waitcnt lgkmcnt(0)" ::: "memory"); __builtin_amdgcn_s_barrier(); asm volatile("" ::: "memory"); } while (0)
#define SW_MMA(buf_) do { const LAS unsigned char* AB_ = L + (buf_) * SW_BUF + (64 * wm + r32) * SW_P + 16 * hh; const LAS unsigned char* BB_ = L + (buf_) * SW_BUF + SW_ABYTES + (64 * wn + r32) * SW_P + 16 * hh; \
        _Pragma("unroll") for (int ks = 0; ks < 4; ++ks) { const bf16x8 a0_ = *(const LAS bf16x8*)(AB_ + 32 * ks), a1_ = *(const LAS bf16x8*)(AB_ + 32 * SW_P + 32 * ks), w0_ = *(const LAS bf16x8*)(BB_ + 32 * ks), w1_ = *(const LAS bf16x8*)(BB_ + 32 * SW_P + 32 * ks); \
            acc[0][0] = __builtin_amdgcn_mfma_f32_32x32x16_bf16(w0_, a0_, acc[0][0], 0, 0, 0); acc[0][1] = __builtin_amdgcn_mfma_f32_32x32x16_bf16(w1_, a0_, acc[0][1], 0, 0, 0); \
            acc[1][0] = __builtin_amdgcn_mfma_f32_32x32x16_bf16(w0_, a1_, acc[1][0], 0, 0, 0); acc[1][1] = __builtin_amdgcn_mfma_f32_32x32x16_bf16(w1_, a1_, acc[1][1], 0, 0, 0); } } while (0)
        f32x16 acc[2][2];
#pragma unroll
        for (int a_ = 0; a_ < 2; ++a_)
#pragma unroll
            for (int b_ = 0; b_ < 2; ++b_)
#pragma unroll
                for (int r = 0; r < 16; ++r) acc[a_][b_][r] = 0.f;
        SW_LOAD(sa0, sb0, 0); SW_LOAD(sa1, sb1, 1);
        SW_STORE(0, sa0, sb0); if (nkt > 2) SW_LOAD(sa0, sb0, 2); SW_SYNC();
        for (int kt = 0; kt < nkt; kt += 2) {
            SW_STORE(1, sa1, sb1);
            if (kt + 3 < nkt) SW_LOAD(sa1, sb1, kt + 3);
            SW_MMA(0);
            SW_SYNC();
            if (kt + 2 < nkt) SW_STORE(0, sa0, sb0);
            if (kt + 4 < nkt) SW_LOAD(sa0, sb0, kt + 4);
            SW_MMA(1);
            SW_SYNC();
        }
#undef SW_LOAD
#undef SW_STORE
#undef SW_SYNC
#undef SW_MMA
#pragma unroll
        for (int tb = 0; tb < 2; ++tb) { const int row = row0 + 64 * wm + 32 * tb + r32;
            float mu_ = 0.f, rstd_ = 1.f;
            if (Emit::NEEDS) { if (E.stp) { const pg8::f32x2e ms = pg8::stat_get(E.stp, row); mu_ = ms.x; rstd_ = ms.y; } }
#pragma unroll
            for (int cb = 0; cb < 2; ++cb)
#pragma unroll
                for (int r4 = 0; r4 < 4; ++r4) { const f32x4 v = {acc[tb][cb][4 * r4 + 0], acc[tb][cb][4 * r4 + 1], acc[tb][cb][4 * r4 + 2], acc[tb][cb][4 * r4 + 3]}; (void)E(row, n0 + 64 * wn + 32 * cb + 8 * r4 + 4 * hh, v, mu_, rstd_); } }
    }
}

__device__ __forceinline__ void y_phase(const Ctx& C, const bf16* Rb, const float* st, const float* gam, const float* bet, float* y) {
    const int lane = __builtin_amdgcn_mbcnt_hi(~0u, __builtin_amdgcn_mbcnt_lo(~0u, 0u));
    int row = C.gw;
    pg8::f32x2e ms = {0.f, 0.f}; v4u w[4];
    if (row < NTOK) { ms = pg8::stat_get(st, row); const v4u* rr = (const v4u*)(Rb + (size_t)row * DM) + lane;
#pragma unroll
        for (int j = 0; j < 4; ++j) w[j] = rr[64 * j]; }
    while (row < NTOK) {
        const int nrow = row + C.NGW; pg8::f32x2e nms = ms; v4u nw[4];
#pragma unroll
        for (int j = 0; j < 4; ++j) nw[j] = w[j];
        if (nrow < NTOK) { nms = pg8::stat_get(st, nrow); const v4u* rr = (const v4u*)(Rb + (size_t)nrow * DM) + lane;
#pragma unroll
            for (int j = 0; j < 4; ++j) nw[j] = rr[64 * j]; }
#pragma unroll
        for (int j = 0; j < 4; ++j) { const v4u ww = w[j]; const int c = 8 * (lane + 64 * j);
            const f32x4 v0 = {bflo(ww.x), bfhi(ww.x), bflo(ww.y), bfhi(ww.y)}, v1 = {bflo(ww.z), bfhi(ww.z), bflo(ww.w), bfhi(ww.w)};
            *(f32x4*)(y + (size_t)row * DM + c) = (v0 - ms.x) * ms.y * *(const f32x4*)(gam + c) + *(const f32x4*)(bet + c);
            *(f32x4*)(y + (size_t)row * DM + c + 4) = (v1 - ms.x) * ms.y * *(const f32x4*)(gam + c + 4) + *(const f32x4*)(bet + c + 4); }
        row = nrow; ms = nms;
#pragma unroll
        for (int j = 0; j < 4; ++j) w[j] = nw[j];
    }
}

namespace pg8 { struct AffineOrder { int n, pm0, dpm, pn0, dpn = 0;
    __device__ __forceinline__ bool next(int i, Unit& u) const { if (i >= n) return false; int pm_ = pm0 + dpm * i, pn_ = pn0 + dpn * i; asm volatile("" : "+s"(pm_), "+s"(pn_)); u.pm = pm_; u.pn = pn_; return true; }
    __device__ __forceinline__ void a_ready(const Unit&) const {}
    __device__ __forceinline__ void done(const Unit&) const {} }; }
__device__ __forceinline__ void mrg_arrive(unsigned* cnt) {
    asm volatile("s_waitcnt vmcnt(0)" ::: "memory"); __syncthreads();
    if (threadIdx.x == 0) { __builtin_amdgcn_fence(__ATOMIC_RELEASE, "agent"); asm volatile("s_waitcnt vmcnt(0)" ::: "memory"); (void)xb_add(cnt, 1u); }
}
__device__ __forceinline__ void mrg_arrive_xcd(unsigned* loc, unsigned* cnt, const XcdBarrier& b) {
    asm volatile("s_waitcnt vmcnt(0)" ::: "memory"); __syncthreads();
    if (threadIdx.x == 0) {
        const unsigned nloc = b.st[0];
        const unsigned old = xb_add(loc + 64 * b.x, 1u);
        if (old + 1u == nloc) { __builtin_amdgcn_fence(__ATOMIC_RELEASE, "agent"); asm volatile("s_waitcnt vmcnt(0)" ::: "memory"); (void)xb_add(cnt, nloc); }
    }
}
__device__ __forceinline__ void mrg_wait(unsigned* cnt, unsigned need, unsigned* bar) {
    if (threadIdx.x == 0) { XB_SPIN(xb_ld(cnt) < need, bar); __builtin_amdgcn_fence(__ATOMIC_ACQUIRE, "agent"); asm volatile("s_waitcnt vmcnt(0)" ::: "memory"); }
    __syncthreads();
}

template <int LAYER> __device__ __forceinline__ void layer_phases(const Ctx& C, const XcdBarrier& bar) {
    constexpr int PH_OUT = LAYER ? 14 : 5, PH_T = LAYER ? 15 : 6;
    LAS unsigned char* const L = C.L; const int G = C.G, bx = C.bx; const int vcu = (G % 8 == 0) ? (bx % 8) * (G / 8) + bx / 8 : bx;
#define STATP(i) (WSP(float, WS_STAT) + (size_t)(i) * NTOK * 2)
#define LNG(idx) (INP(float, idx) + LAYER * DM)
    constexpr size_t R_MIX = LAYER ? WS_X : WS_R, R_MLP = LAYER ? WS_R : WS_X, R_PLE = LAYER ? WS_X : WS_R;
    constexpr size_t B_MIX = LAYER ? WS_XB : WS_G, B_MLP = LAYER ? WS_G : WS_XB, B_PLE = LAYER ? WS_XB : WS_G;
    constexpr int S_MIX = 3 * LAYER, S_MLP = 3 * LAYER + 1, S_PLE = 3 * LAYER + 2;
    if (LAYER == 0) {
        if (IN(4)) {
            KArgs A = kargs(); unsigned char* ws = A->ws;
            pg8::Gemm g{WSP(bf16, WS_G), WSP(bf16, WS_WG), TP, DM, DM}; pg8::StaticOrder S; S.init(TP, DM, G, bx);
            pg8::EpiGate E{WSP(bf16, WS_G), WSP(bf16, WS_T), DM};
            pg8::gemm_phase<pg8::EpiGate, pg8::StaticOrder, true, true>(L + RING_OFF, g, S, E);
            small_gemm(C, WSP(bf16, WS_G), WSP(bf16, WS_WG), DM, DM, vcu, G, SEmitGate{WSP(bf16, WS_G), WSP(bf16, WS_T), nullptr, nullptr});
            SEAM(4);
        }
    } else {
        if (IN(12) && G != 256) {
            KArgs A = kargs(); unsigned char* ws = A->ws; float* out = A->out;
            const float* st = STATP(2); const float* cq = WSP(float, WS_CV) + CV_KVQ;
            pg8::Gemm g{WSP(bf16, WS_G), WSP(bf16, WS_WKVQ), TP, 3072, DM}; pg8::StaticOrder S; S.init(TP, 3072, G, bx);
            pg8::EpiKVQ E{out + O_K_P, out + O_V_P, WSP(bf16, WS_KB), WSP(bf16, WS_VT), WSP(bf16, WS_QB), st, cq, cq + 3072, QSCALE};
            pg8::gemm_phase<pg8::EpiKVQ, pg8::StaticOrder, true, true>(L + RING_OFF, g, S, E);
            { const bool spl = (G == 256);
              if (!spl || bx >= 128) small_gemm(C, WSP(bf16, WS_G), WSP(bf16, WS_WKVQ), 3072, DM, spl ? (bx % 8) * 16 + (bx - 128) / 8 : bx, spl ? 128 : G, SEmitKVQ{out + O_K_S, out + O_V_S, WSP(bf16, WS_QB), st, cq, cq + 3072, nullptr}); }
            SEAM(12);
        }
        if (IN(13)) { if (G == 256) attn_phase_dealt(C); else { attn_prompt_phase(C); attn_sample_phase(C); } SEAM(13); }
    }
    if (IN(PH_OUT)) {
        KArgs A = kargs(); unsigned char* ws = A->ws;
        pg8::Gemm g{LAYER ? WSP(bf16, WS_OB) : WSP(bf16, WS_T), LAYER ? WSP(bf16, WS_WO) : WSP(bf16, WS_WO5), TP, DM, DM}; pg8::StaticOrder S; S.init(TP, DM, G, bx);
        const float* xlo = INP(float, 0); const float* xhi = INP(float, 1) - (size_t)TP * DM; const bf16* xbp = WSP(bf16, WS_G);
        const float* stp = LAYER ? STATP(2) : nullptr; const float* gp = INP(float, 32); const float* bp = INP(float, 33);
        pg8::EpiRes E{xlo, xhi, xbp, stp, gp, bp, nullptr, WSP(bf16, B_MIX), STATP(S_MIX), DM, DN_ALPHA};
        pg8::gemm_phase<pg8::EpiRes, pg8::StaticOrder, true, true>(L + RING_OFF, g, S, E);
        small_gemm(C, LAYER ? WSP(bf16, WS_OB) : WSP(bf16, WS_T), LAYER ? WSP(bf16, WS_WO) : WSP(bf16, WS_WO5), DM, DM, vcu, G, SEmitRes{xhi, xbp, stp, gp, bp, nullptr, WSP(bf16, B_MIX), STATP(S_MIX)});
        SEAM(PH_OUT);
    }
    if (IN(PH_T + 1)) {
        KArgs A = kargs(); unsigned char* ws = A->ws;
        const float* cm = WSP(float, WS_CV) + (LAYER ? CV_M1_1 : CV_M1_0);
        const int x = bx & 7, r = bx >> 3; const bool special = r >= 28;
        unsigned* cntA = (unsigned*)(ws + WS_CTL) + CW_MRG + LAYER * 128; unsigned* cntB = cntA + 64;
        pg8::Gemm g1{WSP(bf16, B_MIX), WSP(bf16, LAYER ? WS_W1_1 : WS_W1_0), NTOK, DFF, DM};
        pg8::EpiAct<1> E1{WSP(bf16, WS_H), DFF, STATP(S_MIX), cm, cm + DFF};
        { pg8::AffineOrder S{1, r & 7, 0, 4 * x + (r >> 3)}; pg8::gemm_phase<pg8::EpiAct<1>, pg8::AffineOrder, true, true>(L + RING_OFF, g1, S, E1); }
        unsigned* locA = (unsigned*)(ws + WS_CTL) + CW_MRGL + LAYER * 2048; unsigned* locB = locA + 1024;
        mrg_arrive_xcd(locA, cntA, bar);
        if (!special) { pg8::AffineOrder S{4, 8 + r % 7, 7, 4 * x + r / 7}; pg8::gemm_phase<pg8::EpiAct<1>, pg8::AffineOrder, true, true>(L + RING_OFF, g1, S, E1); }
        mrg_arrive_xcd(locB, cntB, bar);
        mrg_wait(special ? cntA : cntB, (unsigned)G, bar.bar);
        pg8::Gemm g2{WSP(bf16, WS_H), WSP(bf16, LAYER ? WS_W2_1 : WS_W2_0), NTOK, DM, DFF};
        pg8::EpiRes E2{nullptr, nullptr, WSP(bf16, B_MIX), STATP(S_MIX), LNG(24), LNG(25), nullptr, WSP(bf16, B_MLP), STATP(S_MLP), DM, DN_ALPHA};
        { pg8::AffineOrder S; S.n = special ? 2 : 1; S.pm0 = special ? 2 * (x >> 1) : 8 + 7 * (x >> 1) + r % 7; S.dpm = 1; S.pn0 = 4 * (x & 1) + (special ? r - 28 : r / 7);
          pg8::gemm_phase<pg8::EpiRes, pg8::AffineOrder, true, true>(L + RING_OFF, g2, S, E2); }
        SEAM(PH_T + 1);
    }
    if (LAYER == 0 && G == 256) { if (IN(PH_T + 4)) {
#define PK_PLE(order_) do { KArgs A = kargs(); unsigned char* ws = A->ws; const float* cp = WSP(float, WS_CV) + CV_PL_0; \
            pg8::Gemm gP{WSP(bf16, B_MLP), WSP(bf16, WS_WPG_0), NTOK, DM, DM}; \
            pg8::EpiPle EP{WSP(bf16, B_MLP), WSP(bf16, WS_E0), STATP(S_MLP), LNG(28), LNG(29), cp, cp + DM, nullptr, WSP(bf16, B_PLE), STATP(S_PLE), DM, DN_ALPHA}; \
            pg8::AffineOrder S = order_; pg8::gemm_phase<pg8::EpiPle, pg8::AffineOrder, true, true>(L + RING_OFF, gP, S, EP); } while (0)
#define PK_KVQ(order_) do { KArgs A = kargs(); unsigned char* ws = A->ws; float* out = A->out; const float* cq = WSP(float, WS_CV) + CV_KVQ; \
            pg8::Gemm gK{WSP(bf16, WS_G), WSP(bf16, WS_WKVQ), NTOK, 3072, DM}; \
            pg8::EpiKVQ EK{out + O_K_P, out + O_V_P, WSP(bf16, WS_KB), WSP(bf16, WS_VT), WSP(bf16, WS_QB), STATP(2), cq, cq + 3072, QSCALE}; \
            pg8::AffineOrder S = order_; pg8::gemm_phase<pg8::EpiKVQ, pg8::AffineOrder, true, true>(L + RING_OFF, gK, S, EK); } while (0)
#define PK_KVQS(order_) do { KArgs A = kargs(); unsigned char* ws = A->ws; float* out = A->out; const float* cq = WSP(float, WS_CV) + CV_KVQ; \
            pg8::Gemm gK{WSP(bf16, WS_G), WSP(bf16, WS_WKVQ), NTOK, 3072, DM}; \
            pg8::EpiKVQS EK{out + O_K_S, out + O_V_S, WSP(bf16, WS_QB), STATP(2), cq, cq + 3072, QSCALE}; \
            pg8::AffineOrder S = order_; pg8::gemm_phase<pg8::EpiKVQS, pg8::AffineOrder, true, true>(L + RING_OFF, gK, S, EK); } while (0)
#define PK_CNT(i_) ((unsigned*)(kargs()->ws + WS_CTL) + CW_MRG + 256 + 64 * (i_))
#define PK_LOC(i_) ((unsigned*)(kargs()->ws + WS_CTL) + CW_MRGL + 4096 + 1024 * (i_))
        { const int x = bx & 7, r = bx >> 3; PK_PLE((pg8::AffineOrder{1, 8 * (x >> 1) + (r & 7), 0, 4 * (x & 1) + (r >> 3), 0})); }
        mrg_arrive_xcd(PK_LOC(0), PK_CNT(0), bar);
        if ((bx >> 3) >= 28) { { const int x = bx & 7, r = bx >> 3; PK_PLE((pg8::AffineOrder{1, 32 + (r - 28), 0, x, 0})); } }
        mrg_arrive_xcd(PK_LOC(1), PK_CNT(1), bar);
        mrg_wait(PK_CNT(0), 256u, bar.bar);
        {
            const int x = bx & 7, r = bx >> 3; PK_KVQ((pg8::AffineOrder{(r < 16) ? 2 : 1, 8 * (x >> 1) + (r & 7), 0, 6 * (x & 1) + (r >> 3), 4})); }
        if ((bx >> 3) >= 16 && (bx >> 3) < 22) {
            mrg_wait(PK_CNT(1), 256u, bar.bar);
            const int v = 6 * (bx & 7) + ((bx >> 3) - 16); PK_KVQS((pg8::AffineOrder{1, 32 + (v & 3), 0, v >> 2, 0})); }
#undef PK_PLE
#undef PK_KVQ
#undef PK_KVQS
#undef PK_CNT
#undef PK_LOC
        SEAM(PH_T + 4);
    } } else
    if (IN(PH_T + 4)) {
        KArgs A = kargs(); unsigned char* ws = A->ws;
        const float* cp = WSP(float, WS_CV) + (LAYER ? CV_PL_1 : CV_PL_0);
        pg8::Gemm g{WSP(bf16, B_MLP), WSP(bf16, LAYER ? WS_WPG_1 : WS_WPG_0), TP, DM, DM}; pg8::StaticOrder S; S.init(TP, DM, G, bx);
        pg8::EpiPle E{WSP(bf16, B_MLP), WSP(bf16, LAYER ? WS_E1 : WS_E0), STATP(S_MLP), LNG(28), LNG(29), cp, cp + DM, nullptr, WSP(bf16, B_PLE), STATP(S_PLE), DM, DN_ALPHA};
        pg8::gemm_phase<pg8::EpiPle, pg8::StaticOrder, true, true>(L + RING_OFF, g, S, E);
        small_gemm(C, WSP(bf16, B_MLP), WSP(bf16, LAYER ? WS_WPG_1 : WS_WPG_0), DM, DM, vcu, G, SEmitPle{WSP(bf16, B_MLP), WSP(bf16, LAYER ? WS_E1 : WS_E0), STATP(S_MLP), LNG(28), LNG(29), cp, cp + DM, nullptr, WSP(bf16, B_PLE), STATP(S_PLE)});
        SEAM(PH_T + 4);
    }
    if (LAYER == 1) { if (IN(PH_T + 5)) { KArgs A = kargs(); unsigned char* ws = A->ws; y_phase(C, WSP(bf16, B_PLE), STATP(S_PLE), LNG(32), LNG(33), A->out + O_Y); } }
#undef STATP
#undef LNG
}

__global__ void __launch_bounds__(NWAVES * 64, 2) skel_fwd(Args args) {
    extern __shared__ __attribute__((aligned(16))) unsigned char lds[];
    Ctx C; C.L = (LAS unsigned char*)lds;
    LAS unsigned char* const L = C.L;
    volatile LAS unsigned* const MISC = (volatile LAS unsigned*)(L + MISC_OFF);
    C.tid = threadIdx.x; C.lane = C.tid & 63; C.wave = __builtin_amdgcn_readfirstlane(C.tid >> 6);
    C.G = gridDim.x; C.bx = blockIdx.x; C.lo = args.ph_lo; C.hi = args.ph_hi;
    C.gw = C.wave * C.G + C.bx; C.NGW = C.G * NWAVES;
    const int tid = C.tid, lane = C.lane, wave = C.wave, G = C.G, bx = C.bx, gw = C.gw, NGW = C.NGW;
    const int vcu = (G % 8 == 0) ? (bx % 8) * (G / 8) + bx / 8 : bx;
    for (int u = tid; u < (LDS_BYTES - LDSCTL_OFF) / 4; u += NWAVES * 64) ((LAS unsigned*)(L + LDSCTL_OFF))[u] = 0u;
    __syncthreads();
    const bool use_bar = (C.hi - C.lo) > 1;
    XcdBarrier bar; bar.bar = (unsigned*)(args.ws + WS_CTL) + CW_BAR + args.li * XCD_BAR_WORDS; bar.x = 0; bar.st = nullptr;
    if (use_bar) bar = xcd_barrier_post((unsigned*)(args.ws + WS_CTL) + CW_BAR + args.li * XCD_BAR_WORDS, MISC + 8);

    if (IN(0)) {
        KArgs A = kargs(); unsigned char* ws = A->ws;
        LAS float* scr = (LAS float*)(L + RING_OFF + wave * 16384);
        constexpr int I_SQ = (DM / 64) * (DM / 32), I_W1 = (DM / 64) * (DFF / 32), I_W2 = (DFF / 64) * (DM / 32), I_PP = (PLED / 64) * (DM / 32), I_KV = (DM / 64) * (512 / 32);
        constexpr int PER_L = I_W1 + I_W2 + I_PP + I_SQ;
        constexpr int NITEMS = 4 * I_SQ + 2 * I_KV + 2 * PER_L;
        for (int it = gw; it < NITEMS; it += NGW) {
            int r = it;
            if (r < I_SQ) { p0_transpose_item(INP(float, 17), DM, DM, WSP(bf16, WS_WG), 0, scr, r, lane); continue; } r -= I_SQ;
            if (r < I_SQ) { p0_transpose_item(INP(float, 18), DM, DM, WSP(bf16, WS_WO5), 0, scr, r, lane); continue; } r -= I_SQ;
            { const float* gq = INP(float, 32); const float* bq = INP(float, 33); float* cq = WSP(float, WS_CV) + CV_KVQ;
            if (r < I_KV) { p0_transpose_item(INP(float, 19), DM, 512, WSP(bf16, WS_WKVQ), 0, scr, r, lane, gq, bq, cq, cq + 3072); continue; } r -= I_KV;
            if (r < I_KV) { p0_transpose_item(INP(float, 20), DM, 512, WSP(bf16, WS_WKVQ), 512, scr, r, lane, gq, bq, cq, cq + 3072); continue; } r -= I_KV;
            if (r < I_SQ) { p0_transpose_item(INP(float, 21), DM, DM, WSP(bf16, WS_WKVQ), 1024, scr, r, lane, gq, bq, cq, cq + 3072); continue; } r -= I_SQ; }
            if (r < I_SQ) { p0_transpose_item(INP(float, 22), DM, DM, WSP(bf16, WS_WO), 0, scr, r, lane); continue; } r -= I_SQ;
            const int l = r / PER_L; r -= l * PER_L;
            if (r < I_W1) { float* cm = WSP(float, WS_CV) + (l ? CV_M1_1 : CV_M1_0);
                p0_transpose_item(INP(float, 26) + (size_t)l * DM * DFF, DM, DFF, WSP(bf16, l ? WS_W1_1 : WS_W1_0), 0, scr, r, lane, INP(float, 24) + l * DM, INP(float, 25) + l * DM, cm, cm + DFF); continue; } r -= I_W1;
            if (r < I_W2) { p0_transpose_item(INP(float, 27) + (size_t)l * DM * DFF, DFF, DM, WSP(bf16, l ? WS_W2_1 : WS_W2_0), 0, scr, r, lane); continue; } r -= I_W2;
            if (r < I_PP) { p0_transpose_item(INP(float, 30) + (size_t)l * PLED * DM, PLED, DM, WSP(bf16, l ? WS_WPP_1 : WS_WPP_0), 0, scr, r, lane); continue; } r -= I_PP;
            { float* cp = WSP(float, WS_CV) + (l ? CV_PL_1 : CV_PL_0);
              p0_transpose_item(INP(float, 31) + (size_t)l * DM * DM, DM, DM, WSP(bf16, l ? WS_WPG_1 : WS_WPG_0), 0, scr, r, lane, INP(float, 28) + l * DM, INP(float, 29) + l * DM, cp, cp + DM); }
        }
        const float* p_prompt = INP(float, 2); const float* p_sample = INP(float, 3); bf16* Pb = WSP(bf16, WS_PB);
        for (int i = bx * 512 + tid; i < 2 * NTOK * PLED / 4; i += G * 512) {
            const int l = i / (NTOK * PLED / 4), rem = i % (NTOK * PLED / 4), row = rem / (PLED / 4), c4 = rem % (PLED / 4);
            const float* src = row < TP ? p_prompt + ((size_t)l * TP + row) * PLED + 4 * c4 : p_sample + ((size_t)l * NSMP + (row - TP)) * PLED + 4 * c4;
            const f32x4 v = *(const f32x4*)src; unsigned long long o = (unsigned long long)pk2(v.x, v.y) | ((unsigned long long)pk2(v.z, v.w) << 32);
            *(unsigned long long*)(Pb + ((size_t)l * NTOK + row) * PLED + 4 * c4) = o;
        }
        __syncthreads();
    }

    if (IN(1)) {
        KArgs A = kargs(); unsigned char* ws = A->ws; float* Sloc = WSP(float, WS_HS); const float* x_prompt = INP(float, 0);
        LAS float* tile = (LAS float*)(L + RING_OFF + wave * S5_WAVE_LDS);
        const int tk = lane & 15, kq = lane >> 4;
        f32x4s P; bf16x8 bop[16], cop_unused[8];
        s5_operands<false>(A, bx & 127, lane, tile + 16 * S5_TS, P, bop, cop_unused);
        for (int it = gw; it < NG * (S5_NCH - 1); it += NGW) {
            const int g = it & 127, c = it >> 7;
            float hr = 0.f, hi_ = 0.f;
            const float* xl = x_prompt + (size_t)(c * S5_L + tk) * DM + g * 16 + 8 * (kq & 1);
            f32x4 xa0 = *(const f32x4*)xl, xa1 = *(const f32x4*)(xl + 4);
            for (int sb = 0; sb < S5_SB; ++sb) {
                const bf16x8 aop = s5_aop(xa0, xa1, kq);
                if (sb + 1 < S5_SB) { xa0 = *(const f32x4*)(xl + (size_t)(sb + 1) * 16 * DM); xa1 = *(const f32x4*)(xl + (size_t)(sb + 1) * 16 * DM + 4); }
                s5_bu(aop, bop, tile, lane);
#pragma unroll
                for (int s2 = 0; s2 < 16; ++s2) { const float br = tile[s2 * S5_TS + lane], bi = tile[s2 * S5_TS + 64 + lane]; const float nr = P[0] * hr - P[1] * hi_ + br, ni = P[0] * hi_ + P[1] * hr + bi; hr = nr; hi_ = ni; }
            }
            Sloc[((size_t)c * NG + g) * 128 + lane] = hr; Sloc[((size_t)c * NG + g) * 128 + 64 + lane] = hi_;
        }
        SEAM(1);
    }

    if (IN(2)) {
        KArgs A = kargs(); unsigned char* ws = A->ws; float* out = A->out; const float* Sloc = WSP(float, WS_HS); bf16* Gb = WSP(bf16, WS_G);
        const float* x_prompt = INP(float, 0); const float* x_sample = INP(float, 1); const float* st_re = INP(float, 4); const float* st_im = INP(float, 5); const float* s5_d = INP(float, 16);
        LAS float* tile = (LAS float*)(L + RING_OFF + wave * S5_WAVE_LDS);
        const int tk = lane & 15, kq = lane >> 4;
        f32x4s P; bf16x8 bop[16], cop[8];
        s5_operands<true>(A, bx & 127, lane, tile + 16 * S5_TS, P, bop, cop);
        constexpr int NPI = NG * S5_NCH, NSI = NG * (DECB / 16);
        for (int it = gw; it < NPI + NSI; it += NGW) {
            const bool isp = it < NPI; const int g = it & 127; const int c = isp ? (it >> 7) : 0; const int bq = isp ? 0 : ((it - NPI) >> 7);
            const float dcol = s5_d[g * 16 + tk];
            float hr = 0.f, hi_ = 0.f;
            if (isp) {
                for (int j0 = 0; j0 < c; j0 += 8) {
                    float sr[8], si[8];
#pragma unroll
                    for (int u = 0; u < 8; ++u) { int j = j0 + u; j = j < c ? j : c - 1; sr[u] = Sloc[((size_t)j * NG + g) * 128 + lane]; si[u] = Sloc[((size_t)j * NG + g) * 128 + 64 + lane]; }
#pragma unroll
                    for (int u = 0; u < 8; ++u) { if (j0 + u < c) { const float nr = P[2] * hr - P[3] * hi_ + sr[u], ni = P[2] * hi_ + P[3] * hr + si[u]; hr = nr; hi_ = ni; } }
                } }
            const int nsb = isp ? S5_SB : 8; const int row0 = isp ? c * S5_L : TP + bq * 128;
            const float* xb = (isp ? x_prompt + (size_t)row0 * DM : x_sample + (size_t)(row0 - TP) * DM) + g * 16;
            const float* xl = xb + (size_t)tk * DM + 8 * (kq & 1);
            const float* xe = xb + (size_t)(4 * kq) * DM + tk;
            f32x4 xa0 = *(const f32x4*)xl, xa1 = *(const f32x4*)(xl + 4);
            float xv[4];
#pragma unroll
            for (int i = 0; i < 4; ++i) xv[i] = xe[(size_t)i * DM];
            for (int sb = 0; sb < nsb; ++sb) {
                const int rowb = row0 + sb * 16;
                const bf16x8 aop = s5_aop(xa0, xa1, kq);
                float xc[4];
#pragma unroll
                for (int i = 0; i < 4; ++i) xc[i] = xv[i];
                if (sb + 1 < nsb) { const size_t o = (size_t)(sb + 1) * 16 * DM; xa0 = *(const f32x4*)(xl + o); xa1 = *(const f32x4*)(xl + o + 4);
#pragma unroll
                    for (int i = 0; i < 4; ++i) xv[i] = xe[o + (size_t)i * DM]; }
                s5_bu(aop, bop, tile, lane);
                const size_t sb0 = ((size_t)(16 * bq + 2 * sb) * NG + g) * 64 + lane;
                if (!isp) { hr = st_re[sb0]; hi_ = st_im[sb0]; }
#pragma unroll
                for (int s2 = 0; s2 < 16; ++s2) {
                    if (s2 == 8 && !isp) { out[O_SRE_S + sb0] = hr; out[O_SIM_S + sb0] = hi_; hr = st_re[sb0 + NG * 64]; hi_ = st_im[sb0 + NG * 64]; }
                    const float br = tile[s2 * S5_TS + lane], bi = tile[s2 * S5_TS + 64 + lane]; const float nr = P[0] * hr - P[1] * hi_ + br, ni = P[0] * hi_ + P[1] * hr + bi; hr = nr; hi_ = ni;
                    tile[s2 * S5_TS + lane] = hr; tile[s2 * S5_TS + 64 + lane] = hi_;
                }
                if (!isp) { out[O_SRE_S + sb0 + NG * 64] = hr; out[O_SIM_S + sb0 + NG * 64] = hi_; }
                f32x4s ya = {0.f, 0.f, 0.f, 0.f}, yb = {0.f, 0.f, 0.f, 0.f};
#pragma unroll
                for (int ks = 0; ks < 4; ++ks) {
                    const LAS f32x4* hp = (const LAS f32x4*)(tile + tk * S5_TS + 32 * ks + 8 * kq); const f32x4 h0 = hp[0], h1 = hp[1];
                    v4u hh_; hh_.x = hi_pair(h0.x, h0.y); hh_.y = hi_pair(h0.z, h0.w); hh_.z = hi_pair(h1.x, h1.y); hh_.w = hi_pair(h1.z, h1.w);
                    v4u hl_; hl_.x = lo_pair(h0.x, h0.y, hh_.x); hl_.y = lo_pair(h0.z, h0.w, hh_.y); hl_.z = lo_pair(h1.x, h1.y, hh_.z); hl_.w = lo_pair(h1.z, h1.w, hh_.w);
                    const bf16x8 ah = __builtin_bit_cast(bf16x8, hh_), al = __builtin_bit_cast(bf16x8, hl_);
                    ya = __builtin_amdgcn_mfma_f32_16x16x32_bf16(ah, cop[2 * ks], ya, 0, 0, 0);
                    yb = __builtin_amdgcn_mfma_f32_16x16x32_bf16(al, cop[2 * ks], yb, 0, 0, 0);
                    ya = __builtin_amdgcn_mfma_f32_16x16x32_bf16(ah, cop[2 * ks + 1], ya, 0, 0, 0);
                }
                const f32x4s y = ya + yb;
#pragma unroll
                for (int i = 0; i < 4; ++i) { const float v = y[i] + dcol * xc[i]; Gb[(size_t)(rowb + 4 * kq + i) * DM + g * 16 + tk] = (bf16)cvtpk(gelu_tanh(v), 0.f); }
            }
            if (isp && c == S5_NCH - 1) { out[O_SRE_P + g * 64 + lane] = hr; out[O_SIM_P + g * 64 + lane] = hi_; }
        }
        __syncthreads();
    }

    if (IN(3)) {
        { KArgs A = kargs(); unsigned char* ws = A->ws;
          pg8::Gemm g{WSP(bf16, WS_PB), WSP(bf16, WS_WPP_0), TP, DM, PLED}; pg8::StaticOrder S; S.init(TP, DM, G, bx);
          pg8::EpiAct<0> E{WSP(bf16, WS_E0), DM};
          pg8::gemm_phase<pg8::EpiAct<0>, pg8::StaticOrder, false, false>(L + RING_OFF, g, S, E);
          small_gemm(C, WSP(bf16, WS_PB), WSP(bf16, WS_WPP_0), DM, PLED, vcu, G, SEmitAct<0>{WSP(bf16, WS_E0), DM}); }
        __syncthreads();
        { KArgs A = kargs(); unsigned char* ws = A->ws;
          pg8::Gemm g{WSP(bf16, WS_PB) + (size_t)NTOK * PLED, WSP(bf16, WS_WPP_1), TP, DM, PLED}; pg8::StaticOrder S; S.init(TP, DM, G, bx);
          pg8::EpiAct<0> E{WSP(bf16, WS_E1), DM};
          pg8::gemm_phase<pg8::EpiAct<0>, pg8::StaticOrder, false, false>(L + RING_OFF, g, S, E);
          small_gemm(C, WSP(bf16, WS_PB) + (size_t)NTOK * PLED, WSP(bf16, WS_WPP_1), DM, PLED, vcu, G, SEmitAct<0>{WSP(bf16, WS_E1), DM}); }
        SEAM(3);
    }

    layer_phases<0>(C, bar);
    layer_phases<1>(C, bar);
}
#undef IN
#undef BOTH
#undef SEAM

constexpr int N_PHASES = 21;
#ifndef MK_N_LAUNCHES
#define MK_N_LAUNCHES 1
#endif
extern "C" void kernel_launch(void* const* d_in, const int* in_sizes, int n_in, void* d_out, int out_size, void* d_ws, size_t ws_size, hipStream_t stream) {
    static int grid = 0;
    if (grid == 0) {
        if (n_in != 34 || out_size != (int)O_END || ws_size < WS_END) { fprintf(stderr, "kernel_launch: unexpected shapes: n_in %d out %d ws %zu\n", n_in, out_size, ws_size); grid = -1; return; }
        int dev = 0, cus = 0, per_cu = 0;
        if (hipGetDevice(&dev) != hipSuccess || hipDeviceGetAttribute(&cus, hipDeviceAttributeMultiprocessorCount, dev) != hipSuccess) { grid = -1; return; }
        if (hipFuncSetAttribute((const void*)skel_fwd, hipFuncAttributeMaxDynamicSharedMemorySize, LDS_BYTES) != hipSuccess) { fprintf(stderr, "kernel_launch: hipFuncSetAttribute failed\n"); grid = -1; return; }
        if (hipOccupancyMaxActiveBlocksPerMultiprocessor(&per_cu, (const void*)skel_fwd, NWAVES * 64, LDS_BYTES) != hipSuccess || per_cu < 1) fprintf(stderr, "kernel_launch: occupancy query reports %d\n", per_cu);
        (void)hipGetLastError();
        grid = cus;
        if (grid != 256) { fprintf(stderr, "kernel_launch: the merged MLP deal is written for 256 workgroups (got %d CUs)\n", grid); grid = -1; return; }
        if (grid % 128 != 0) { fprintf(stderr, "kernel_launch: this build deals S5 groups by blockIdx %% 128 and needs a CU count that is a multiple of 128 (got %d)\n", grid); grid = -1; return; }
    }
    if (grid < 0) return;
    (void)hipMemsetAsync((char*)d_ws + WS_CTL, 0, CTL_ZERO_BYTES, stream);
    Args a{};
    for (int i = 0; i < 34; ++i) a.in[i] = d_in[i];
    a.out = (float*)d_out; a.ws = (unsigned char*)d_ws;
    constexpr int NL = MK_N_LAUNCHES;
    for (int li = 0; li < NL; ++li) {
        a.ph_lo = (NL == N_PHASES) ? li : (li * N_PHASES) / NL; a.ph_hi = (NL == N_PHASES) ? li + 1 : ((li + 1) * N_PHASES) / NL; a.li = li; a.pad = 0;
        hipLaunchKernelGGL(skel_fwd, dim3(grid), dim3(NWAVES * 64), LDS_BYTES, stream, a);
    }
}
```

```cpp
#include <hip/hip_runtime.h>
#include <cstdio>
#include <cstdint>
namespace pg8 {
#define PG8_LAS __attribute__((address_space(3)))
typedef unsigned short bf16_t;
typedef short bf16x8 __attribute__((ext_vector_type(8)));
typedef float f32x4 __attribute__((ext_vector_type(4)));
typedef unsigned u32x4 __attribute__((ext_vector_type(4)));
constexpr int BM = 256, BK = 64, HALF = 128, HTB = HALF * BK * 2  , STAGE_BYTES = 8 * HTB, NXCD = 8, WGM = 8;

__host__ __device__ __forceinline__ int lds_byte(int r, int c) { const int st = (r >> 4) * 2 + (c >> 5), rr = r & 15, cc = c & 31, ob = rr * 64 + cc * 2; return st * 1024 + (ob ^ (((ob >> 9) & 1) << 5)); }
__host__ __device__ __forceinline__ void stage_rc(int b, int& R, int& C) { const int st = b / 1024, sb = b % 1024, swz = sb ^ (((sb >> 9) & 1) << 5); R = (st >> 1) * 16 + swz / 64; C = (st & 1) * 32 + (swz % 64) / 2; }
__host__ __device__ __forceinline__ int perm32(int rho) { const int n = rho >> 4, i = rho & 15; return 8 * (i >> 2) + 4 * n + (i & 3); }

struct Unit { int pm, pn; };
struct Gemm { const bf16_t* A; const bf16_t* Bt; int M, N, K; };

struct StaticOrder {
    int nM, nN, nwg, G, c;
    __host__ __device__ void init(int M, int N, int G_, int c_) { nM = M / BM; nN = N / BM; nwg = nM * nN; G = G_; c = c_; }
    __host__ __device__ bool next(int i, Unit& u) const {
        const long L = (long)i * G + c; if (L >= nwg) return false;
        int wgid = (int)L; { const int q = nwg / NXCD, r = nwg % NXCD, xcd = wgid % NXCD, off = wgid / NXCD; wgid = (xcd < r ? xcd * (q + 1) : r * (q + 1) + (xcd - r) * q) + off; }
        const int nig = WGM * nN, gid = wgid / nig, fm = gid * WGM, gsz = (nM - fm) < WGM ? (nM - fm) : WGM;
        u.pm = fm + ((wgid % nig) % gsz); u.pn = (wgid % nig) / gsz; return true;
    }
    __device__ __forceinline__ void a_ready(const Unit&) const {}
    __device__ __forceinline__ void done(const Unit&) const {}
};

__device__ __forceinline__ unsigned cvt_pk_bf16(float lo, float hi) { unsigned r; asm volatile("v_cvt_pk_bf16_f32 %0, %1, %2" : "=v"(r) : "v"(lo), "v"(hi)); return r; }
typedef float f32x2 __attribute__((ext_vector_type(2)));
typedef unsigned u32x2 __attribute__((ext_vector_type(2)));
typedef float f32x2e __attribute__((ext_vector_type(2)));
constexpr float EPI_INV_D = 1.0f / 2048.0f, EPI_EPS = 1e-5f;
__device__ __forceinline__ float bf_lo(unsigned w) { return __uint_as_float(w << 16); }
__device__ __forceinline__ float bf_hi(unsigned w) { return __uint_as_float(w & 0xffff0000u); }
__device__ __forceinline__ float sigm(float x) { return __builtin_amdgcn_rcpf(1.f + __expf(-x)); }
__device__ __forceinline__ u32x2 pack4(f32x4 v) { u32x2 w; w.x = cvt_pk_bf16(v[0], v[1]); w.y = cvt_pk_bf16(v[2], v[3]); return w; }
__host__ __device__ __forceinline__ int perm16(int k) { return (k & 3) | (((k >> 3) & 1) << 2) | (((k >> 2) & 1) << 3); }
__device__ __forceinline__ f32x2e stat_get(const float* st, int row) { const f32x2e v = *(const f32x2e*)(st + 2 * (size_t)row); const float mu = v.x * EPI_INV_D; const float var = v.y * EPI_INV_D - mu * mu; return (f32x2e){mu, __builtin_amdgcn_rsqf(var + EPI_EPS)}; }
__device__ __forceinline__ void stat_add(float* st, int row, float s, float q, int fq) { s += __shfl_xor(s, 16); s += __shfl_xor(s, 32); q += __shfl_xor(q, 16); q += __shfl_xor(q, 32); if (fq < 2) atomicAdd(st + 2 * (size_t)row + fq, fq ? q : s); }

struct EpiGate { static constexpr bool PERM = true, AFTER_DRAIN = false; const bf16_t* Gm; bf16_t* O; int ldc;
    __device__ __forceinline__ void operator()(const f32x4 (&acc)[2][2][4][2], const Unit& u, int wr, int wc, int fr, int fq) const {
        const int row0 = u.pm * BM + wr * 64 + fr, col0 = u.pn * BM + wc * 32 + 8 * fq;
#pragma unroll
        for (int ai = 0; ai < 2; ++ai)
#pragma unroll
            for (int m = 0; m < 4; ++m) { const size_t off = (size_t)(row0 + ai * HALF + m * 16) * ldc + col0;
#pragma unroll
                for (int bj = 0; bj < 2; ++bj) { const u32x4 g = *(const u32x4*)(Gm + off + bj * HALF); const f32x4 v0 = acc[ai][bj][m][0], v1 = acc[ai][bj][m][1];
                    u32x4 w;
                    w.x = cvt_pk_bf16(bf_lo(g.x) * sigm(v0[0]), bf_hi(g.x) * sigm(v0[1]));
                    w.y = cvt_pk_bf16(bf_lo(g.y) * sigm(v0[2]), bf_hi(g.y) * sigm(v0[3]));
                    w.z = cvt_pk_bf16(bf_lo(g.z) * sigm(v1[0]), bf_hi(g.z) * sigm(v1[1]));
                    w.w = cvt_pk_bf16(bf_lo(g.w) * sigm(v1[2]), bf_hi(g.w) * sigm(v1[3]));
                    *(u32x4*)(O + off + bj * HALF) = w; } }
    }
};
template <int ACT> struct EpiAct { static constexpr bool PERM = true, AFTER_DRAIN = false; bf16_t* O; int ldc; const float* st; const float* c1; const float* c2;
    __device__ __forceinline__ void operator()(const f32x4 (&acc)[2][2][4][2], const Unit& u, int wr, int wc, int fr, int fq) const {
        const int row0 = u.pm * BM + wr * 64 + fr, col0 = u.pn * BM + wc * 32 + 8 * fq;
        f32x2e ms[8];
#pragma unroll
        for (int i = 0; i < 8; ++i) ms[i] = (ACT == 1) ? stat_get(st, row0 + (i >> 2) * HALF + (i & 3) * 16) : (f32x2e){0.f, 1.f};
#pragma unroll
        for (int bj = 0; bj < 2; ++bj) { const int c = col0 + bj * HALF; f32x4 a0 = {0.f, 0.f, 0.f, 0.f}, a1 = a0, b0 = a0, b1 = a0;
            if (ACT == 1) { a0 = *(const f32x4*)(c1 + c); a1 = *(const f32x4*)(c1 + c + 4); b0 = *(const f32x4*)(c2 + c); b1 = *(const f32x4*)(c2 + c + 4); }
#pragma unroll
            for (int i = 0; i < 8; ++i) { const int ai = i >> 2, m = i & 3; const size_t off = (size_t)(row0 + ai * HALF + m * 16) * ldc + c; f32x4 v0 = acc[ai][bj][m][0], v1 = acc[ai][bj][m][1];
                if (ACT == 1) { v0 = (v0 - a0 * ms[i].x) * ms[i].y + b0; v1 = (v1 - a1 * ms[i].x) * ms[i].y + b1;
#pragma unroll
                    for (int k = 0; k < 4; ++k) { const float a = fmaxf(v0[k], 0.f), b = fmaxf(v1[k], 0.f); v0[k] = a * a; v1[k] = b * b; } }
                u32x4 w; w.x = cvt_pk_bf16(v0[0], v0[1]); w.y = cvt_pk_bf16(v0[2], v0[3]); w.z = cvt_pk_bf16(v1[0], v1[1]); w.w = cvt_pk_bf16(v1[2], v1[3]);
                *(u32x4*)(O + off) = w; } }
    }
};
__device__ __forceinline__ void unpack8(u32x4 w, f32x4& lo, f32x4& hi) { lo = (f32x4){bf_lo(w.x), bf_hi(w.x), bf_lo(w.y), bf_hi(w.y)}; hi = (f32x4){bf_lo(w.z), bf_hi(w.z), bf_lo(w.w), bf_hi(w.w)}; }
__device__ __forceinline__ u32x4 pack8f(f32x4 lo, f32x4 hi) { u32x4 w; w.x = cvt_pk_bf16(lo[0], lo[1]); w.y = cvt_pk_bf16(lo[2], lo[3]); w.z = cvt_pk_bf16(hi[0], hi[1]); w.w = cvt_pk_bf16(hi[2], hi[3]); return w; }
__device__ __forceinline__ float sum4(f32x4 v) { return (v[0] + v[1]) + (v[2] + v[3]); }
__device__ __forceinline__ float sq4(f32x4 v) { return (v[0] * v[0] + v[1] * v[1]) + (v[2] * v[2] + v[3] * v[3]); }
struct EpiRes { static constexpr bool PERM = true, AFTER_DRAIN = false; const float* xlo; const float* xhi; const bf16_t* xb; const float* stp; const float* gp; const float* bp; float* R; bf16_t* Rb; float* stn; int ldc; float alpha;
    __device__ __forceinline__ void operator()(const f32x4 (&acc)[2][2][4][2], const Unit& u, int wr, int wc, int fr, int fq) const {
        const float* X = (u.pm < 32) ? xlo : xhi; const int col0 = u.pn * BM + wc * 32 + 8 * fq;
#pragma unroll
        for (int ai = 0; ai < 2; ++ai)
#pragma unroll
            for (int m = 0; m < 4; ++m) { const int row = u.pm * BM + ai * HALF + wr * 64 + m * 16 + fr; const size_t off = (size_t)row * ldc + col0;
                f32x2e ms = {0.f, 1.f}; if (stp) ms = stat_get(stp, row);
                float s = 0.f, q = 0.f;
#pragma unroll
                for (int bj = 0; bj < 2; ++bj) { const int co = bj * HALF; f32x4 x0, x1;
                    if (stp) { unpack8(*(const u32x4*)(xb + off + co), x0, x1);
                        const f32x4 g0 = *(const f32x4*)(gp + col0 + co), g1 = *(const f32x4*)(gp + col0 + co + 4), b0 = *(const f32x4*)(bp + col0 + co), b1 = *(const f32x4*)(bp + col0 + co + 4);
                        x0 = (x0 - ms.x) * ms.y * g0 + b0; x1 = (x1 - ms.x) * ms.y * g1 + b1; }
                    else { x0 = *(const f32x4*)(X + off + co); x1 = *(const f32x4*)(X + off + co + 4); }
                    const f32x4 r0 = x0 * alpha + acc[ai][bj][m][0], r1 = x1 * alpha + acc[ai][bj][m][1];
                    if (R) { *(f32x4*)(R + off + co) = r0; *(f32x4*)(R + off + co + 4) = r1; }
                    *(u32x4*)(Rb + off + co) = pack8f(r0, r1);
                    s += sum4(r0) + sum4(r1); q += sq4(r0) + sq4(r1); }
                stat_add(stn, row, s, q, fq); }
    }
};
struct EpiPle { static constexpr bool PERM = true, AFTER_DRAIN = false; const bf16_t* X; const bf16_t* E; const float* stp; const float* gp; const float* bp; const float* c1; const float* c2; float* R; bf16_t* Rb; float* stn; int ldc; float alpha;
    __device__ __forceinline__ void operator()(const f32x4 (&acc)[2][2][4][2], const Unit& u, int wr, int wc, int fr, int fq) const {
        const int col0 = u.pn * BM + wc * 32 + 8 * fq;
#pragma unroll
        for (int ai = 0; ai < 2; ++ai)
#pragma unroll
            for (int m = 0; m < 4; ++m) { const int row = u.pm * BM + ai * HALF + wr * 64 + m * 16 + fr; const size_t off = (size_t)row * ldc + col0;
                const f32x2e ms = stat_get(stp, row);
                float s = 0.f, q = 0.f;
#pragma unroll
                for (int bj = 0; bj < 2; ++bj) { const int co = bj * HALF; const int cc = col0 + co; f32x4 x0, x1, e0, e1;
                    unpack8(*(const u32x4*)(X + off + co), x0, x1); unpack8(*(const u32x4*)(E + off + co), e0, e1);
                    { const f32x4 g0 = *(const f32x4*)(gp + cc), g1 = *(const f32x4*)(gp + cc + 4), b0 = *(const f32x4*)(bp + cc), b1 = *(const f32x4*)(bp + cc + 4); x0 = (x0 - ms.x) * ms.y * g0 + b0; x1 = (x1 - ms.x) * ms.y * g1 + b1; }
                    f32x4 v0, v1;
                    { const f32x4 a0 = *(const f32x4*)(c1 + cc), a1 = *(const f32x4*)(c1 + cc + 4), d0 = *(const f32x4*)(c2 + cc), d1 = *(const f32x4*)(c2 + cc + 4); v0 = (acc[ai][bj][m][0] - a0 * ms.x) * ms.y + d0; v1 = (acc[ai][bj][m][1] - a1 * ms.x) * ms.y + d1; }
                    f32x4 r0, r1;
#pragma unroll
                    for (int k = 0; k < 4; ++k) { r0[k] = x0[k] * alpha + e0[k] * sigm(v0[k]); r1[k] = x1[k] * alpha + e1[k] * sigm(v1[k]); }
                    if (R) { *(f32x4*)(R + off + co) = r0; *(f32x4*)(R + off + co + 4) = r1; }
                    if (Rb) *(u32x4*)(Rb + off + co) = pack8f(r0, r1);
                    s += sum4(r0) + sum4(r1); q += sq4(r0) + sq4(r1); }
                stat_add(stn, row, s, q, fq); }
    }
};
struct EpiKVQ { static constexpr bool PERM = false, AFTER_DRAIN = false; float* kp; float* vp; bf16_t* Kb; bf16_t* Vt; bf16_t* Qb; const float* st; const float* c1; const float* c2; float qscale;
    __device__ __forceinline__ void operator()(const f32x4 (&acc)[2][2][4][2], const Unit& u, int wr, int wc, int fr, int fq) const {
        const int colt = u.pn * BM + wc * 32 + 4 * fq;
#pragma unroll
        for (int ai = 0; ai < 2; ++ai)
#pragma unroll
            for (int m = 0; m < 4; ++m) { const int r = u.pm * BM + ai * HALF + wr * 64 + m * 16 + fr; const f32x2e ms = stat_get(st, r);
#pragma unroll
                for (int bj = 0; bj < 2; ++bj)
#pragma unroll
                    for (int n = 0; n < 2; ++n) { const int c = colt + bj * HALF + n * 16; const f32x4 a4 = *(const f32x4*)(c1 + c), d4 = *(const f32x4*)(c2 + c);
                        const f32x4 v = (acc[ai][bj][m][n] - a4 * ms.x) * ms.y + d4;
                        if (u.pn < 2) { *(f32x4*)(kp + (size_t)r * 512 + c) = v; *(u32x2*)(Kb + (size_t)r * 512 + c) = pack4(v); }
                        else if (u.pn < 4) { const int cc = c - 512; *(f32x4*)(vp + (size_t)r * 512 + cc) = v;
                            const u32x2 pk = pack4(v); const int pr = (r & ~15) | perm16(r & 15);
                            Vt[(size_t)(cc + 0) * 8192 + pr] = (bf16_t)(pk.x & 0xffffu); Vt[(size_t)(cc + 1) * 8192 + pr] = (bf16_t)(pk.x >> 16);
                            Vt[(size_t)(cc + 2) * 8192 + pr] = (bf16_t)(pk.y & 0xffffu); Vt[(size_t)(cc + 3) * 8192 + pr] = (bf16_t)(pk.y >> 16); }
                        else { const int qc = c - 1024; *(u32x2*)(Qb + (size_t)r * 2048 + qc) = pack4(v * qscale); } } }
    }
};
struct EpiKVQS { static constexpr bool PERM = false, AFTER_DRAIN = false; float* ks; float* vs; bf16_t* Qb; const float* st; const float* c1; const float* c2; float qscale;
    __device__ __forceinline__ void operator()(const f32x4 (&acc)[2][2][4][2], const Unit& u, int wr, int wc, int fr, int fq) const {
        const int colt = u.pn * BM + wc * 32 + 4 * fq;
#pragma unroll
        for (int ai = 0; ai < 2; ++ai)
#pragma unroll
            for (int m = 0; m < 4; ++m) { const int r = u.pm * BM + ai * HALF + wr * 64 + m * 16 + fr; const f32x2e ms = stat_get(st, r);
#pragma unroll
                for (int bj = 0; bj < 2; ++bj)
#pragma unroll
                    for (int n = 0; n < 2; ++n) { const int c = colt + bj * HALF + n * 16; const f32x4 a4 = *(const f32x4*)(c1 + c), d4 = *(const f32x4*)(c2 + c);
                        const f32x4 v = (acc[ai][bj][m][n] - a4 * ms.x) * ms.y + d4;
                        if (u.pn < 2) *(f32x4*)(ks + (size_t)(r - 8192) * 512 + c) = v;
                        else if (u.pn < 4) *(f32x4*)(vs + (size_t)(r - 8192) * 512 + (c - 512)) = v;
                        else *(u32x2*)(Qb + (size_t)r * 2048 + (c - 1024)) = pack4(v * qscale); } }
    }
};


template <class Epi, class Sched, bool ALIGN_EPI = false, bool SP2 = false>
__device__ __forceinline__ void gemm_phase(PG8_LAS unsigned char* lds, const Gemm g, const Sched& S, const Epi& E) {
    const int tid = threadIdx.x, wid = __builtin_amdgcn_readfirstlane(tid >> 6), lane = tid & 63, wr = wid >> 2, wc = wid & 3, fr = lane & 15, fq = lane >> 4;
    const int K = g.K, nt = K / BK;
    unsigned voffA[2], voffB[2];
#pragma unroll
    for (int i = 0; i < 2; ++i) { int R, C; stage_rc(tid * 16 + i * 8192, R, C); const int Rb = Epi::PERM ? ((R & ~31) + perm32(R & 31)) : R;
        voffA[i] = (unsigned)(R * K + C) * 2u; voffB[i] = (unsigned)(Rb * K + C) * 2u; }
    const size_t kstep = (size_t)(BK * 2);
    const size_t hstep = (size_t)HALF * K * 2;
    const size_t tstep = 2 * hstep;
    const unsigned ldsw = (unsigned)wid * 1024u;
    const int aoff = lds_byte(wr * 64 + fr, fq * 8), boff = lds_byte(wc * 32 + fr, fq * 8);
#define PG8_SA(b, h) (((b) * 2 + (h)) * HTB)
#define PG8_SB(b, h) ((4 + (b) * 2 + (h)) * HTB)
#define PG8_STAGE(bufoff, gbase, voff) do { _Pragma("unroll") for (int _i = 0; _i < 2; ++_i) \
        __builtin_amdgcn_global_load_lds((const unsigned*)((const char*)(gbase) + (voff)[_i]), (PG8_LAS unsigned*)(lds + (bufoff) + ldsw + _i * 8192), 16, 0, 0); } while (0)
#define PG8_LDA(dst, b, h) do { _Pragma("unroll") for (int m = 0; m < 4; ++m) _Pragma("unroll") for (int k = 0; k < 2; ++k) dst[m][k] = *(const PG8_LAS bf16x8*)(lds + PG8_SA(b, h) + aoff + m * 2048 + k * 1024); } while (0)
#define PG8_LDB(dst, b, h) do { _Pragma("unroll") for (int n = 0; n < 2; ++n) _Pragma("unroll") for (int k = 0; k < 2; ++k) dst[n][k] = *(const PG8_LAS bf16x8*)(lds + PG8_SB(b, h) + boff + n * 2048 + k * 1024); } while (0)
#define PG8_MMA(ai, bj, At, Bt) do { __builtin_amdgcn_s_setprio(1); _Pragma("unroll") for (int m = 0; m < 4; ++m) _Pragma("unroll") for (int n = 0; n < 2; ++n) _Pragma("unroll") for (int k = 0; k < 2; ++k) \
        acc[ai][bj][m][n] = __builtin_amdgcn_mfma_f32_16x16x32_bf16(Bt[n][k], At[m][k], acc[ai][bj][m][n], 0, 0, 0); __builtin_amdgcn_s_setprio(0); } while (0)
#define PG8_WAIT_V(n) asm volatile("s_waitcnt vmcnt(" #n ")" ::: "memory")
#define PG8_WAIT_L(n) asm volatile("s_waitcnt lgkmcnt(" #n ")" ::: "memory")
#define PG8_BAR __builtin_amdgcn_s_barrier()
#define PG8_SCHED __builtin_amdgcn_sched_barrier(0)
    Unit cur, nxt; int ui = 0;
    if (!S.next(0, cur)) return;
    f32x4 acc[2][2][4][2];
#pragma unroll
    for (int a = 0; a < 2; ++a)
#pragma unroll
        for (int b = 0; b < 2; ++b)
#pragma unroll
            for (int m = 0; m < 4; ++m)
#pragma unroll
                for (int n = 0; n < 2; ++n) acc[a][b][m][n] = (f32x4){0.f, 0.f, 0.f, 0.f};
    bf16x8 At[4][2], B0[2][2], B1[2][2];
    const char* cA = (const char*)g.A + (size_t)cur.pm * tstep; const char* cB = (const char*)g.Bt + (size_t)cur.pn * tstep;
    S.a_ready(cur);
    if constexpr (SP2) {
        PG8_STAGE(PG8_SB(0, 0), cB, voffB); PG8_STAGE(PG8_SB(0, 1), cB + hstep, voffB); PG8_STAGE(PG8_SA(0, 0), cA, voffA); PG8_STAGE(PG8_SA(0, 1), cA + hstep, voffA);
        if (wr == 1) PG8_BAR;
        PG8_WAIT_V(2); PG8_BAR;
        PG8_STAGE(PG8_SB(1, 0), cB + kstep, voffB); PG8_STAGE(PG8_SA(1, 0), cA + kstep, voffA); PG8_STAGE(PG8_SB(1, 1), cB + hstep + kstep, voffB);
        PG8_WAIT_V(6); PG8_BAR;
    } else {
        PG8_STAGE(PG8_SB(0, 0), cB, voffB); PG8_STAGE(PG8_SA(0, 0), cA, voffA); PG8_STAGE(PG8_SB(0, 1), cB + hstep, voffB); PG8_STAGE(PG8_SA(0, 1), cA + hstep, voffA);
        if (wr == 1) PG8_BAR;
        PG8_WAIT_V(4); PG8_BAR;
        PG8_STAGE(PG8_SB(1, 0), cB + kstep, voffB); PG8_STAGE(PG8_SA(1, 0), cA + kstep, voffA); PG8_STAGE(PG8_SB(1, 1), cB + hstep + kstep, voffB);
        PG8_WAIT_V(6); PG8_BAR;
    }
    for (;;) {
        const bool has_next = S.next(ui + 1, nxt);
        const char* nA = has_next ? (const char*)g.A + (size_t)nxt.pm * tstep : cA; const char* nB = has_next ? (const char*)g.Bt + (size_t)nxt.pn * tstep : cB;
        for (int t = 0; t < nt; t += 2) {
            const bool last = (t == nt - 2);
            const char* a1 = cA + (size_t)(t + 1) * kstep;
            const char* a2 = last ? nA : cA + (size_t)(t + 2) * kstep; const char* b2 = last ? nB : cB + (size_t)(t + 2) * kstep;
            const char* a3 = a2 + kstep; const char* b3 = b2 + kstep;
            if (last && has_next) S.a_ready(nxt);
            if constexpr (SP2) {
            PG8_LDB(B0, 0, 0); PG8_LDB(B1, 0, 1); PG8_SCHED; PG8_LDA(At, 0, 0); PG8_STAGE(PG8_SA(1, 1), a1 + hstep, voffA);
            PG8_WAIT_V(8); PG8_WAIT_L(0); PG8_BAR; PG8_MMA(0, 0, At, B0); PG8_MMA(0, 1, At, B1); PG8_BAR; PG8_SCHED;
            PG8_LDA(At, 0, 1); PG8_STAGE(PG8_SB(0, 0), b2, voffB); PG8_STAGE(PG8_SB(0, 1), b2 + hstep, voffB); PG8_STAGE(PG8_SA(0, 0), a2, voffA);
            PG8_WAIT_V(8); PG8_WAIT_L(0); PG8_BAR; PG8_MMA(1, 0, At, B0); PG8_MMA(1, 1, At, B1); PG8_BAR; PG8_SCHED;
            PG8_LDB(B0, 1, 0); PG8_LDB(B1, 1, 1); PG8_SCHED; PG8_LDA(At, 1, 0); PG8_STAGE(PG8_SA(0, 1), a2 + hstep, voffA);
            PG8_WAIT_V(8); PG8_WAIT_L(0); PG8_BAR; PG8_MMA(0, 0, At, B0); PG8_MMA(0, 1, At, B1); PG8_BAR; PG8_SCHED;
            PG8_LDA(At, 1, 1); PG8_STAGE(PG8_SB(1, 0), b3, voffB); PG8_STAGE(PG8_SB(1, 1), b3 + hstep, voffB); PG8_STAGE(PG8_SA(1, 0), a3, voffA);
            PG8_WAIT_V(8); PG8_WAIT_L(0); PG8_BAR; PG8_MMA(1, 0, At, B0); PG8_MMA(1, 1, At, B1); PG8_BAR; PG8_SCHED;
            } else {
            PG8_LDB(B0, 0, 0); PG8_SCHED; PG8_LDA(At, 0, 0); PG8_STAGE(PG8_SA(1, 1), a1 + hstep, voffA);
            PG8_WAIT_L(8); PG8_BAR; PG8_WAIT_L(0); PG8_MMA(0, 0, At, B0); PG8_BAR; PG8_SCHED;
            PG8_LDB(B1, 0, 1); PG8_STAGE(PG8_SB(0, 0), b2, voffB);
            PG8_BAR; PG8_WAIT_L(0); PG8_MMA(0, 1, At, B1); PG8_BAR;
            PG8_LDA(At, 0, 1); PG8_STAGE(PG8_SA(0, 0), a2, voffA);
            PG8_BAR; PG8_WAIT_L(0); PG8_MMA(1, 0, At, B0); PG8_BAR; PG8_SCHED;
            PG8_STAGE(PG8_SB(0, 1), b2 + hstep, voffB);
            PG8_WAIT_V(6); PG8_BAR; PG8_MMA(1, 1, At, B1); PG8_BAR;
            PG8_LDB(B0, 1, 0); PG8_SCHED; PG8_LDA(At, 1, 0); PG8_STAGE(PG8_SA(0, 1), a2 + hstep, voffA);
            PG8_WAIT_L(8); PG8_BAR; PG8_WAIT_L(0); PG8_MMA(0, 0, At, B0); PG8_BAR; PG8_SCHED;
            PG8_LDB(B1, 1, 1); PG8_STAGE(PG8_SB(1, 0), b3, voffB);
            PG8_BAR; PG8_WAIT_L(0); PG8_MMA(0, 1, At, B1); PG8_BAR;
            PG8_LDA(At, 1, 1); PG8_STAGE(PG8_SA(1, 0), a3, voffA);
            PG8_BAR; PG8_WAIT_L(0); PG8_MMA(1, 0, At, B0); PG8_BAR; PG8_SCHED;
            PG8_STAGE(PG8_SB(1, 1), b3 + hstep, voffB);
            PG8_WAIT_V(6); PG8_BAR; PG8_MMA(1, 1, At, B1); PG8_BAR;
            }
        }
        if constexpr (ALIGN_EPI) { if (wr == 0) PG8_BAR; }
        if constexpr (!Epi::AFTER_DRAIN) { E(acc, cur, wr, wc, fr, fq); S.done(cur); }
        if (!has_next) break;
#pragma unroll
        for (int a = 0; a < 2; ++a)
#pragma unroll
            for (int b = 0; b < 2; ++b)
#pragma unroll
                for (int m = 0; m < 4; ++m)
#pragma unroll
                    for (int n = 0; n < 2; ++n) acc[a][b][m][n] = (f32x4){0.f, 0.f, 0.f, 0.f};
        cur = nxt; cA = nA; cB = nB; ++ui;
        if constexpr (ALIGN_EPI) { if (wr == 1) PG8_BAR; }
    }
    PG8_WAIT_V(0);
    if constexpr (!ALIGN_EPI) { if (wr == 0) PG8_BAR; }
    PG8_BAR;
    if constexpr (Epi::AFTER_DRAIN) { E.fused(acc, cur, wr, wc, fr, fq, lds, wid, lane); S.done(cur); }
#undef PG8_SA
#undef PG8_SB
#undef PG8_STAGE
#undef PG8_LDA
#undef PG8_LDB
#undef PG8_MMA
#undef PG8_WAIT_V
#undef PG8_WAIT_L
#undef PG8_BAR
#undef PG8_SCHED
}
}
#define GAS __attribute__((address_space(1)))
#define LAS __attribute__((address_space(3)))
typedef unsigned short bf16;
typedef unsigned v4u __attribute__((ext_vector_type(4)));
typedef float f32x4 __attribute__((ext_vector_type(4)));
typedef short bf16x8 __attribute__((ext_vector_type(8)));
typedef GAS unsigned gu32;
typedef GAS unsigned long long gu64;
#define RLX_AGENT __ATOMIC_RELAXED, __HIP_MEMORY_SCOPE_AGENT
#define LDS_WAIT() asm volatile("s_waitcnt lgkmcnt(0)" ::: "memory")
#define VM_WAIT() asm volatile("s_waitcnt vmcnt(0)" ::: "memory")
__device__ __forceinline__ unsigned long long rt() { return __builtin_amdgcn_s_memrealtime(); }
__device__ __forceinline__ unsigned f2bf(float f) { unsigned u = __builtin_bit_cast(unsigned, f); return (u + 0x7fffu + ((u >> 16) & 1u)) >> 16; }
__device__ __forceinline__ unsigned pk2(float lo, float hi) { return f2bf(lo) | (f2bf(hi) << 16); }

#define XB_TMO      128
#define XB_XCNT(j)  (256  + 64 * (j))
#define XB_XSUB(j)  (1280 + 64 * (j))
#define XB_XGEN(j)  (2304 + 64 * (j))
#define XB_TOP      3328
#define XB_TOPGEN   3392
#define XCD_BAR_WORDS 3456
#define XB_SPIN_CAP (1u << 18)

__device__ __forceinline__ unsigned xb_ld(unsigned* p)              { return __hip_atomic_load(p, __ATOMIC_RELAXED, __HIP_MEMORY_SCOPE_AGENT); }
__device__ __forceinline__ unsigned xb_add(unsigned* p, unsigned v) { return __hip_atomic_fetch_add(p, v, __ATOMIC_RELAXED, __HIP_MEMORY_SCOPE_AGENT); }
__device__ __forceinline__ unsigned xb_xcc_id() { return (unsigned)__builtin_amdgcn_s_getreg((3 << 11) | 20) & 0xFu; }
#define XB_SPIN(cond, bar) do { unsigned _sp = 0; while (cond) { __builtin_amdgcn_s_sleep(1); \
    if ((++_sp & 255u) == 0u) { if (xb_ld(&(bar)[XB_TMO])) break; if (_sp > XB_SPIN_CAP) { atomicAdd(&(bar)[XB_TMO], 1u); break; } } } } while (0)

struct XcdBarrier {
    unsigned* bar; unsigned x;
    volatile LAS unsigned* st;
};

__device__ __forceinline__ XcdBarrier xcd_barrier_post(unsigned* bar, volatile LAS unsigned* st) {
    XcdBarrier b; b.bar = bar; b.x = xb_xcc_id(); b.st = st;
    if (threadIdx.x == 0) (void)xb_add(&bar[XB_XCNT(b.x)], 1u);
    return b;
}
__device__ __forceinline__ void xcd_barrier_complete(unsigned* bar, unsigned x, unsigned& nloc, unsigned& nx) {
    const unsigned G = gridDim.x * gridDim.y * gridDim.z;
    unsigned sum, cnt, mine, sp = 0u;
    for (;;) {
        sum = 0u; cnt = 0u; mine = 0u;
#pragma unroll
        for (unsigned j = 0; j < 16; ++j) { const unsigned c = xb_ld(&bar[XB_XCNT(j)]); sum += c; cnt += (c > 0u) ? 1u : 0u; mine = (j == x) ? c : mine; }
        if (sum == G) break;
        __builtin_amdgcn_s_sleep(1);
        if ((++sp & 255u) == 0u) { if (xb_ld(&bar[XB_TMO])) break; if (sp > XB_SPIN_CAP) { atomicAdd(&bar[XB_TMO], 1u); break; } }
    }
    nloc = mine > 0u ? mine : 1u; nx = cnt > 0u ? cnt : 1u;
}

__device__ __forceinline__ void xcd_barrier(const XcdBarrier& b) {
    asm volatile("s_waitcnt vmcnt(0)" ::: "memory");
    __syncthreads();
    if (threadIdx.x == 0) {
        unsigned* bar = b.bar;
        __builtin_amdgcn_s_waitcnt(0);
        unsigned nloc = b.st[0], nx = b.st[1];
        if (nloc == 0u) { xcd_barrier_complete(bar, b.x, nloc, nx); b.st[0] = nloc; b.st[1] = nx; }
        const unsigned old = xb_add(&bar[XB_XSUB(b.x)], 1u);
        const unsigned gen = old / nloc;
        if (old + 1u == (gen + 1u) * nloc) {
            __builtin_amdgcn_fence(__ATOMIC_RELEASE, "agent");
            asm volatile("s_waitcnt vmcnt(0)" ::: "memory");
            const unsigned og = xb_add(&bar[XB_TOP], 1u);
            const unsigned tg = og / nx;
            if (og + 1u == (tg + 1u) * nx) xb_add(&bar[XB_TOPGEN], 1u);
            else XB_SPIN(xb_ld(&bar[XB_TOPGEN]) == tg, bar);
            __builtin_amdgcn_fence(__ATOMIC_ACQUIRE, "agent");
            xb_add(&bar[XB_XGEN(b.x)], 1u);
            asm volatile("s_waitcnt vmcnt(0)" ::: "memory");
        } else {
            XB_SPIN(xb_ld(&bar[XB_XGEN(b.x)]) == gen, bar);
            __builtin_amdgcn_fence(__ATOMIC_ACQUIRE, "agent");
            asm volatile("s_waitcnt vmcnt(0)" ::: "memory");
        }
    }
    __syncthreads();
}

constexpr int NWAVES = 8;
constexpr int DM = 2048, TP = 8192, NSMP = 1024, NTOK = 9216, DFF = 8192, PLED = 256, NG = 128, NPST = 64, NKV = 4, HD = 128, NH = 16, PASTL = 2048, NPG = 16, DECB = 128, DECT = 8;
constexpr float LN_EPS = 1e-5f, DN_ALPHA = 1.41421356237f, QSCALE = 0.12751743082459868f, LOG2E = 1.4426950408889634f;
constexpr size_t O_Y = 0, O_SRE_P = 18874368, O_SIM_P = 18882560, O_K_P = 18890752, O_V_P = 23085056, O_SRE_S = 27279360, O_SIM_S = 28327936, O_K_S = 29376512, O_V_S = 29900800, O_END = 30425088;
constexpr size_t MiB = 1u << 20;
constexpr size_t WS_CTL = 0, CTL_ZERO_BYTES = 2 * MiB;
constexpr size_t WS_STAT = 1 * MiB, WS_CV = 1 * MiB + 512 * 1024;
constexpr int CV_M1_0 = 0, CV_PL_0 = 16384, CV_KVQ = 20480, CV_M1_1 = 26624, CV_PL_1 = 43008, CV_END = 47104;
constexpr size_t WS_WG = 2 * MiB, WS_WO5 = 10 * MiB, WS_W1_0 = 18 * MiB, WS_W2_0 = 50 * MiB, WS_WPP_0 = 82 * MiB, WS_WPG_0 = 83 * MiB, WS_WKVQ = 91 * MiB, WS_WO = 103 * MiB,
                 WS_W1_1 = 111 * MiB, WS_W2_1 = 143 * MiB, WS_WPP_1 = 175 * MiB, WS_WPG_1 = 176 * MiB;
constexpr size_t WS_PB = 184 * MiB, WS_E0 = 194 * MiB, WS_E1 = 230 * MiB, WS_G = 266 * MiB, WS_T = 302 * MiB, WS_R = 338 * MiB, WS_X = 410 * MiB, WS_XB = 482 * MiB, WS_H = 518 * MiB;
constexpr size_t WS_KB = 662 * MiB, WS_VB = 670 * MiB, WS_VT = 678 * MiB, WS_QB = 686 * MiB, WS_OB = 722 * MiB, WS_HS = 758 * MiB, WS_END = 1334 * MiB;
constexpr int CW_TMO = 0, CW_BAR = 4096;
constexpr int CW_ATQ = 201000;
constexpr int AT_SMP_R0 = 20;
constexpr int CW_MRGL = 210000;
constexpr int CW_MRG = 200000;
constexpr int RING_OFF = 0, RING_BYTES = 131072, LDSCTL_OFF = RING_BYTES, MISC_OFF = LDSCTL_OFF + 320, LDS_BYTES = 147456;

__device__ __forceinline__ float wave_sum(float v) {
#pragma unroll
    for (int o = 1; o < 64; o <<= 1) v += __shfl_xor(v, o);
    return v;
}
__device__ __forceinline__ float bflo(unsigned w) { return __uint_as_float(w << 16); }
__device__ __forceinline__ float bfhi(unsigned w) { return __uint_as_float(w & 0xffff0000u); }
typedef float f32x2_t __attribute__((ext_vector_type(2))); typedef __bf16 bf16x2_t __attribute__((ext_vector_type(2)));
__device__ __forceinline__ unsigned cvtpk(float lo, float hi) { f32x2_t v = {lo, hi}; bf16x2_t b = __builtin_convertvector(v, bf16x2_t); return __builtin_bit_cast(unsigned, b); }
__device__ __forceinline__ float gelu_tanh(float v) { const float a = v * (2.3022082f + 0.10294324f * (v * v)); return v * __builtin_amdgcn_rcpf(1.f + __builtin_amdgcn_exp2f(-a)); }

__device__ __forceinline__ void p0_transpose_item(const float* W, int K, int N, bf16* WT, int row_off, LAS float* scr, int item, int lane, const float* gv = nullptr, const float* bv = nullptr, float* c1 = nullptr, float* c2 = nullptr) {
    const int nblk = N / 32, kb = item / nblk, nb = item % nblk, k0 = 64 * kb, n0 = 32 * nb;
#pragma unroll 8
    for (int i = 0; i < 32; ++i) { const int kk = 2 * i + (lane >> 5); scr[kk * 33 + (lane & 31)] = W[(size_t)(k0 + kk) * N + n0 + (lane & 31)]; }
    LDS_WAIT(); asm volatile("" ::: "memory");
    if (gv) { const int nn = lane & 31, hf = lane >> 5; float s1 = 0.f, s2 = 0.f;
#pragma unroll 8
        for (int k2 = 0; k2 < 32; ++k2) { const int kk = hf * 32 + k2; const float w = scr[kk * 33 + nn]; s1 += __uint_as_float(f2bf(w * gv[k0 + kk]) << 16); s2 += w * bv[k0 + kk]; }
        s1 += __shfl_xor(s1, 32); s2 += __shfl_xor(s2, 32);
        if (lane < 32) { atomicAdd(c1 + row_off + n0 + nn, s1); atomicAdd(c2 + row_off + n0 + nn, s2); } }
    const int c = lane & 7;
    float g8[8];
#pragma unroll
    for (int j = 0; j < 8; ++j) g8[j] = gv ? gv[k0 + 8 * c + j] : 1.f;
#pragma unroll
    for (int j = 0; j < 4; ++j) { const int n = (lane >> 3) + 8 * j; const LAS float* s = scr + (8 * c) * 33 + n;
        v4u o; o.x = pk2(s[0 * 33] * g8[0], s[1 * 33] * g8[1]); o.y = pk2(s[2 * 33] * g8[2], s[3 * 33] * g8[3]); o.z = pk2(s[4 * 33] * g8[4], s[5 * 33] * g8[5]); o.w = pk2(s[6 * 33] * g8[6], s[7 * 33] * g8[7]);
        *(GAS v4u*)(WT + (size_t)(row_off + n0 + n) * K + k0 + 8 * c) = o; }
    LDS_WAIT(); asm volatile("" ::: "memory");
}

struct Args { const void* in[34]; float* out; unsigned char* ws; int ph_lo, ph_hi, li, pad; };
typedef const __attribute__((address_space(4))) Args* KArgs;
__device__ __forceinline__ KArgs kargs() { KArgs p = (KArgs)__builtin_amdgcn_kernarg_segment_ptr(); asm volatile("" : "+s"(p)); return p; }
#define INP(T, i) ((const T*)A->in[i])
#define WSP(T, off) ((T*)(ws + (off)))

__device__ __forceinline__ void s5_setup(KArgs A, int g, int p, float& ar, float& ai, float (&bbr)[16], float (&bbi)[16]) {
    const float* lam_re = INP(float, 9); const float* lam_im = INP(float, 10); const float* log_dt = INP(float, 11);
    const float* b_re = INP(float, 12); const float* b_im = INP(float, 13);
    const double dt = exp((double)log_dt[g]); const double lr = (double)lam_re[g * 64 + p], li = (double)lam_im[g * 64 + p];
    const double mag = exp(lr * dt); double sn, cs; sincos(li * dt, &sn, &cs);
    const double abr = mag * cs, abi = mag * sn, den = lr * lr + li * li, nr = abr - 1.0;
    const double fr = (nr * lr + abi * li) / den, fi = (abi * lr - nr * li) / den;
    ar = (float)abr; ai = (float)abi;
    const float* br = b_re + ((size_t)g * 64 + p) * 16; const float* bi = b_im + ((size_t)g * 64 + p) * 16;
#pragma unroll
    for (int c = 0; c < 16; ++c) { const double x = (double)br[c], y = (double)bi[c]; bbr[c] = (float)(fr * x - fi * y); bbi[c] = (float)(fr * y + fi * x); }
}


constexpr int S5_L = 256, S5_NCH = TP / S5_L, S5_SB = S5_L / 16, S5_TS = 132;
constexpr int S5_WAVE_LDS = 10240;
constexpr int S5T_PAR = 8 * S5_WAVE_LDS, S5T_BOP = S5T_PAR + 1024, S5T_COP = S5T_BOP + 16384, S5T_F = S5T_COP + 8192;
static_assert(S5T_F + 512 <= RING_BYTES, "S5 LDS tables");
typedef float f32x4s __attribute__((ext_vector_type(4)));
__device__ __forceinline__ unsigned hi_pair(float a, float b) { return cvtpk(a, b); }
__device__ __forceinline__ unsigned lo_pair(float a, float b, unsigned hp) { return cvtpk(a - bflo(hp), b - bfhi(hp)); }
__device__ __forceinline__ f32x4s s5_setup2(KArgs A, int g, int p, LAS float* tab) {
    const float* lam_re = INP(float, 9); const float* lam_im = INP(float, 10); const float* log_dt = INP(float, 11);
    const double dt = exp((double)log_dt[g]); const double lr = (double)lam_re[g * 64 + p], li = (double)lam_im[g * 64 + p];
    const double mag = exp(lr * dt); double sn, cs; sincos(li * dt, &sn, &cs);
    const double abr = mag * cs, abi = mag * sn, den = lr * lr + li * li, nr = abr - 1.0;
    const double fr = (nr * lr + abi * li) / den, fi = (abi * lr - nr * li) / den;
    const double magL = exp(lr * dt * (double)S5_L); double snL, csL; sincos(li * dt * (double)S5_L, &snL, &csL);
    tab[2 * p] = (float)fr; tab[2 * p + 1] = (float)fi;
    return (f32x4s){(float)abr, (float)abi, (float)(magL * csL), (float)(magL * snL)};
}
template <bool WITH_C> __device__ __forceinline__ void s5_operands(KArgs A, int g, int lane, LAS float* tab, f32x4s& P, bf16x8 (&bop)[16], bf16x8 (&cop)[8]) {
    const float* b_re = INP(float, 12); const float* b_im = INP(float, 13); const float* c_re = INP(float, 14); const float* c_im = INP(float, 15);
    P = s5_setup2(A, g, lane, tab);
    const int n = lane & 15, kq = lane >> 4;
#pragma unroll
    for (int nb = 0; nb < 8; ++nb) { const int p = (nb & 3) * 16 + n; const float fr = tab[2 * p], fi = tab[2 * p + 1]; float val[8];
#pragma unroll
        for (int j = 0; j < 8; ++j) { const int ch = (8 * kq + j) & 15; const float x = b_re[((size_t)g * 64 + p) * 16 + ch], y = b_im[((size_t)g * 64 + p) * 16 + ch]; val[j] = (nb < 4) ? fr * x - fi * y : fr * y + fi * x; }
        v4u h, l;
        h.x = hi_pair(val[0], val[1]); h.y = hi_pair(val[2], val[3]); h.z = hi_pair(val[4], val[5]); h.w = hi_pair(val[6], val[7]);
        l.x = lo_pair(val[0], val[1], h.x); l.y = lo_pair(val[2], val[3], h.y); l.z = lo_pair(val[4], val[5], h.z); l.w = lo_pair(val[6], val[7], h.w);
        if (kq >= 2) l = (v4u){0u, 0u, 0u, 0u};
        bop[2 * nb] = __builtin_bit_cast(bf16x8, h); bop[2 * nb + 1] = __builtin_bit_cast(bf16x8, l); }
    if (WITH_C) {
#pragma unroll
        for (int ks = 0; ks < 4; ++ks) { float val[8];
#pragma unroll
            for (int j = 0; j < 8; ++j) { const int k = 32 * ks + 8 * kq + j; const size_t ci = ((size_t)g * 16 + n) * 64 + (k & 63); val[j] = (k < 64) ? c_re[ci] : -c_im[ci]; }
            v4u h, l;
            h.x = hi_pair(val[0], val[1]); h.y = hi_pair(val[2], val[3]); h.z = hi_pair(val[4], val[5]); h.w = hi_pair(val[6], val[7]);
            l.x = lo_pair(val[0], val[1], h.x); l.y = lo_pair(val[2], val[3], h.y); l.z = lo_pair(val[4], val[5], h.z); l.w = lo_pair(val[6], val[7], h.w);
            cop[2 * ks] = __builtin_bit_cast(bf16x8, h); cop[2 * ks + 1] = __builtin_bit_cast(bf16x8, l); } }
}
__device__ __forceinline__ bf16x8 s5_aop(f32x4 xa0, f32x4 xa1, int kq) {
    v4u h; h.x = hi_pair(xa0.x, xa0.y); h.y = hi_pair(xa0.z, xa0.w); h.z = hi_pair(xa1.x, xa1.y); h.w = hi_pair(xa1.z, xa1.w);
    v4u l; l.x = lo_pair(xa0.x, xa0.y, h.x); l.y = lo_pair(xa0.z, xa0.w, h.y); l.z = lo_pair(xa1.x, xa1.y, h.z); l.w = lo_pair(xa1.z, xa1.w, h.w);
    const v4u r = (kq < 2) ? h : l; return __builtin_bit_cast(bf16x8, r);
}
__device__ __forceinline__ void s5_bu(bf16x8 aop, const bf16x8 (&bop)[16], LAS float* tile, int lane) {
    f32x4s acc[8];
#pragma unroll
    for (int nb = 0; nb < 8; ++nb) acc[nb] = __builtin_amdgcn_mfma_f32_16x16x32_bf16(aop, bop[2 * nb], (f32x4s){0.f, 0.f, 0.f, 0.f}, 0, 0, 0);
#pragma unroll
    for (int nb = 0; nb < 8; ++nb) acc[nb] = __builtin_amdgcn_mfma_f32_16x16x32_bf16(aop, bop[2 * nb + 1], acc[nb], 0, 0, 0);
#pragma unroll
    for (int nb = 0; nb < 8; ++nb)
#pragma unroll
        for (int i = 0; i < 4; ++i) tile[(4 * (lane >> 4) + i) * S5_TS + nb * 16 + (lane & 15)] = acc[nb][i];
}

struct Ctx { LAS unsigned char* L; int lo, hi, gw, NGW, G, bx, lane, wave, tid; };
#define IN(k) (C.lo <= (k) && (k) < C.hi)
#define BOTH(k) (IN(k) && IN((k) + 1))
#define SEAM(k) do { if (BOTH(k)) xcd_barrier(bar); } while (0)

typedef float f32x16 __attribute__((ext_vector_type(16)));
constexpr int AT_KP = 256, AT_VP = 128, AT_KBYTES = 64 * AT_KP, AT_VBYTES = 128 * AT_VP, AT_BUF = AT_KBYTES + AT_VBYTES;
static_assert(4 * AT_BUF <= RING_BYTES, "attention LDS");
__device__ __forceinline__ bf16x8 pack8(const f32x16& x, int s) { v4u w; w.x = cvtpk(x[8 * s + 0], x[8 * s + 1]); w.y = cvtpk(x[8 * s + 2], x[8 * s + 3]); w.z = cvtpk(x[8 * s + 4], x[8 * s + 5]); w.w = cvtpk(x[8 * s + 6], x[8 * s + 7]); return __builtin_bit_cast(bf16x8, w); }
#define AT_SB() __builtin_amdgcn_sched_barrier(0)
template <int VBLK> __device__ __forceinline__ void at_step(const LAS unsigned char* kb, const LAS unsigned char* vb, int kq0, int kshi, int vq0, int vsw, const bf16x8 (&qf)[8], const bf16x8 (&ntri)[2],
                                                            f32x16 (&o)[4], f32x16& z, float& Rb, v4u& wp0, v4u& wp1, float cb, int r32) {
#define AT_KF(ks_) (*(const LAS bf16x8*)(kb + kq0 + (((ks_) ^ kshi) << 5)))
#define AT_VF(i_) (*(const LAS bf16x8*)(vb + vq0 + ((i_) & 3) * 32 * AT_VP + (((4 * VBLK + 2 * ((i_) >> 2)) ^ vsw) << 4)))
#define AT_SPC(p_) do { const float e0_ = __builtin_amdgcn_exp2f(z[2 * (p_)]), e1_ = __builtin_amdgcn_exp2f(z[2 * (p_) + 1]); \
        la = __builtin_amdgcn_logf(__builtin_fmaf(e0_, cb, 1.f)); lb = __builtin_amdgcn_logf(__builtin_fmaf(e1_, cb, 1.f)); \
        z[2 * (p_)] -= Rb; z[2 * (p_) + 1] -= Rb; asm volatile("" : "+v"(la), "+v"(lb), "+v"(z[2 * (p_)]), "+v"(z[2 * (p_) + 1])); } while (0)
#define AT_SPK(p_) do { unsigned w_ = cvtpk(la, lb); asm volatile("" : "+v"(w_)); if ((p_) < 4) s0[(p_) & 3] = w_; else s1[(p_) & 3] = w_; } while (0)
#define AT_EXC(p_, ea_, eb_) do { ea_ = __builtin_amdgcn_exp2f(ex[2 * (p_)]); eb_ = __builtin_amdgcn_exp2f(ex[2 * (p_) + 1]); asm volatile("" : "+v"(ea_), "+v"(eb_)); } while (0)
#define AT_EXK(p_, ea_, eb_) do { unsigned w_ = cvtpk(ea_, eb_); asm volatile("" : "+v"(w_)); if ((p_) < 4) n0[(p_) & 3] = w_; else n1[(p_) & 3] = w_; } while (0)
    v4u s0, s1, n0, n1;
    const float zr0 = z[0];
    bf16x8 vfa = AT_VF(0), vfb = AT_VF(1);
    float la, lb, ea, eb, fa, fb;
    AT_SPC(0);
    AT_SB();
    bf16x8 kfa, kfb;
#pragma unroll
    for (int i = 0; i < 8; ++i) {
        bf16x8 vfc = vfb;
        if (i + 2 < 8) vfc = AT_VF(i + 2);
        if (i == 6) kfa = AT_KF(0);
        if (i == 7) kfb = AT_KF(1);
        o[i & 3] = __builtin_amdgcn_mfma_f32_32x32x16_bf16(vfa, __builtin_bit_cast(bf16x8, i < 4 ? wp0 : wp1), o[i & 3], 0, 0, 0);
        AT_SPK(i);
        if (i < 7) AT_SPC(i + 1);
        vfa = vfb; vfb = vfc;
        AT_SB();
    }
    f32x16 ex = __builtin_amdgcn_mfma_f32_32x32x16_bf16(ntri[0], __builtin_bit_cast(bf16x8, s0), z, 0, 0, 0);
    ex = __builtin_amdgcn_mfma_f32_32x32x16_bf16(ntri[1], __builtin_bit_cast(bf16x8, s1), ex, 0, 0, 0);
    f32x16 zn;
#pragma unroll
    for (int r = 0; r < 16; ++r) zn[r] = 0.f;
    {   bf16x8 kfc = AT_KF(2), kfd = AT_KF(3);
        zn = __builtin_amdgcn_mfma_f32_32x32x16_bf16(kfa, qf[0], zn, 0, 0, 0);
        zn = __builtin_amdgcn_mfma_f32_32x32x16_bf16(kfb, qf[1], zn, 0, 0, 0);
        kfa = kfc; kfb = kfd; }
    AT_SB();
    Rb = __shfl(zr0 - ex[0], r32);
#pragma unroll
    for (int i = 2; i < 8; ++i) {
        bf16x8 kfc = kfb;
        if (i + 2 < 8) kfc = AT_KF(i + 2);
        zn = __builtin_amdgcn_mfma_f32_32x32x16_bf16(kfa, qf[i], zn, 0, 0, 0);
        if (i == 2) { AT_EXC(0, ea, eb); AT_EXC(1, fa, fb); } else if (i & 1) { AT_EXK(i - 3, ea, eb); AT_EXC(i - 1, ea, eb); } else { AT_EXK(i - 3, fa, fb); AT_EXC(i - 1, fa, fb); }
        kfa = kfb; kfb = kfc;
        AT_SB();
    }
    AT_EXK(5, fa, fb); AT_EXC(7, fa, fb); AT_EXK(6, ea, eb); AT_EXK(7, fa, fb);
    AT_SB();
    wp0 = n0; wp1 = n1; z = zn;
#undef AT_KF
#undef AT_VF
#undef AT_SPC
#undef AT_SPK
#undef AT_EXC
#undef AT_EXK
}
__device__ __forceinline__ void attn_prompt_unit(const Ctx& C, const bf16* Qb, const bf16* Kb, const bf16* Vt, bf16* Ob, const float* sb_bias, int kvh, int qb) {
    LAS unsigned char* const L = C.L; int lane = C.lane; const int wave = C.wave;
    asm volatile("" : "+v"(lane));
    const int g = wave >> 1, sq = wave & 1, h = kvh * 4 + g, r32 = lane & 31, hh = lane >> 5;
    const int t = 64 * qb + 32 * sq + r32;
    bf16x8 qf[8];
#pragma unroll
    for (int ks = 0; ks < 8; ++ks) qf[ks] = *(const bf16x8*)(Qb + (size_t)t * DM + h * HD + 16 * ks + 8 * hh);
    const float bias2 = sb_bias[h] * LOG2E;
    bf16x8 tri[2];
#pragma unroll
    for (int s = 0; s < 2; ++s)
#pragma unroll
        for (int jj = 0; jj < 8; ++jj) { const int key = 16 * s + 8 * (jj >> 2) + 4 * hh + (jj & 3); tri[s][jj] = (key >= r32) ? (short)0x3F80 : (short)0; }
    f32x16 o[4];
#pragma unroll
    for (int db = 0; db < 4; ++db)
#pragma unroll
        for (int r = 0; r < 16; ++r) o[db][r] = 0.f;
    float R = 0.f;
    const bf16* kg = Kb + kvh * HD; const bf16* vg = Vt + (size_t)kvh * HD * TP;
    const int krr = lane >> 4, kpc = lane & 15, vrr = lane >> 3, vpc = lane & 7;
#define AT_DMA(kt_, buf_) do { _Pragma("unroll") for (int i_ = 0; i_ < 2; ++i_) { const int I_ = 2 * wave + i_; \
        { const int row_ = 4 * I_ + krr; const int c_ = kpc ^ (row_ & 15); __builtin_amdgcn_global_load_lds((const unsigned*)(kg + (size_t)(64 * (kt_) + row_) * 512 + c_ * 8), (LAS unsigned*)(L + (buf_) * AT_BUF + I_ * 1024), 16, 0, 0); } \
        { const int row_ = 8 * I_ + vrr; const int c_ = vpc ^ ((row_ >> 1) & 7); __builtin_amdgcn_global_load_lds((const unsigned*)(vg + (size_t)row_ * TP + 64 * (kt_) + c_ * 8), (LAS unsigned*)(L + (buf_) * AT_BUF + AT_KBYTES + I_ * 1024), 16, 0, 0); } } } while (0)
    __syncthreads();
    AT_DMA(qb, qb & 3);
    if (qb >= 1) AT_DMA(qb - 1, (qb - 1) & 3);
    if (qb >= 2) AT_DMA(qb - 2, (qb - 2) & 3);
    asm volatile("s_waitcnt vmcnt(0)" ::: "memory"); __syncthreads();
    {
        const LAS unsigned char* KB = L + (qb & 3) * AT_BUF; const LAS unsigned char* VB = KB + AT_KBYTES;
#pragma unroll
        for (int kb = 1; kb >= 0; --kb) {
            if (kb > sq) continue;
            f32x16 z;
#pragma unroll
            for (int r = 0; r < 16; ++r) z[r] = bias2;
#pragma unroll
            for (int ks = 0; ks < 8; ++ks) { const bf16x8 kf = *(const LAS bf16x8*)(KB + (32 * kb + r32) * AT_KP + (((2 * ks + hh) ^ (r32 & 15)) << 4)); z = __builtin_amdgcn_mfma_f32_32x32x16_bf16(kf, qf[ks], z, 0, 0, 0); }
            if (kb == sq) {
#pragma unroll
                for (int r = 0; r < 16; ++r) { const int kk = (r & 3) + 8 * (r >> 2) + 4 * hh; if (kk >= r32) z[r] = -INFINITY; } }
            f32x16 sp;
#pragma unroll
            for (int r = 0; r < 16; ++r) sp[r] = __builtin_amdgcn_logf(1.f + __builtin_amdgcn_exp2f(z[r]));
            const bf16x8 sp0 = pack8(sp, 0), sp1 = pack8(sp, 1);
            f32x16 cum;
#pragma unroll
            for (int r = 0; r < 16; ++r) cum[r] = R;
            cum = __builtin_amdgcn_mfma_f32_32x32x16_bf16(tri[0], sp0, cum, 0, 0, 0);
            cum = __builtin_amdgcn_mfma_f32_32x32x16_bf16(tri[1], sp1, cum, 0, 0, 0);
#pragma unroll
            for (int r = 0; r < 16; ++r) sp[r] = __builtin_amdgcn_exp2f(z[r] - cum[r]);
            const bf16x8 w0 = pack8(sp, 0), w1 = pack8(sp, 1);
#pragma unroll
            for (int db = 0; db < 4; ++db) {
                const bf16x8 v0 = *(const LAS bf16x8*)(VB + (32 * db + r32) * AT_VP + (((4 * kb + hh) ^ ((r32 >> 1) & 7)) << 4));
                const bf16x8 v1 = *(const LAS bf16x8*)(VB + (32 * db + r32) * AT_VP + (((4 * kb + 2 + hh) ^ ((r32 >> 1) & 7)) << 4));
                o[db] = __builtin_amdgcn_mfma_f32_32x32x16_bf16(v0, w0, o[db], 0, 0, 0);
                o[db] = __builtin_amdgcn_mfma_f32_32x32x16_bf16(v1, w1, o[db], 0, 0, 0); }
            R = __shfl(cum[0], r32);
        }
    }
    if (qb > 0) {
        bf16x8 ntri[2];
#pragma unroll
        for (int s = 0; s < 2; ++s)
#pragma unroll
            for (int jj = 0; jj < 8; ++jj) ntri[s][jj] = tri[s][jj] ? (short)0xBF80 : (short)0;
        const float cb = __builtin_amdgcn_exp2f(bias2);
        float Rb = R - bias2;
        const int kq0 = r32 * AT_KP + ((hh ^ (r32 & 1)) << 4), kshi = (r32 & 15) >> 1, vq0 = AT_KBYTES + r32 * AT_VP + ((hh ^ ((r32 >> 1) & 1)) << 4), vsw = (r32 >> 1) & 6;
        v4u wp0 = (v4u){0u, 0u, 0u, 0u}, wp1 = wp0;
        f32x16 z;
#pragma unroll
        for (int r = 0; r < 16; ++r) z[r] = 0.f;
        {   const LAS unsigned char* kb = L + ((qb - 1) & 3) * AT_BUF + 32 * AT_KP;
#pragma unroll
            for (int ks = 0; ks < 8; ++ks) { const bf16x8 kf = *(const LAS bf16x8*)(kb + kq0 + ((ks ^ kshi) << 5)); z = __builtin_amdgcn_mfma_f32_32x32x16_bf16(kf, qf[ks], z, 0, 0, 0); } }
        for (int T = qb - 1; T >= 0; --T) {
            asm volatile("s_waitcnt vmcnt(0)" ::: "memory");
            __syncthreads();
            if (T >= 2) AT_DMA(T - 2, (T - 2) & 3);
            const LAS unsigned char* s_hi = L + ((T + 1) & 3) * AT_BUF; const LAS unsigned char* s_cu = L + (T & 3) * AT_BUF; const LAS unsigned char* s_lo = L + ((T - 1) & 3) * AT_BUF;
            at_step<0>(s_cu, s_hi, kq0, kshi, vq0, vsw, qf, ntri, o, z, Rb, wp0, wp1, cb, r32);
            at_step<1>(s_lo + 32 * AT_KP, s_cu, kq0, kshi, vq0, vsw, qf, ntri, o, z, Rb, wp0, wp1, cb, r32);
        }
        {   const LAS unsigned char* vb = L;
#pragma unroll
            for (int i = 0; i < 8; ++i) { const bf16x8 vf = *(const LAS bf16x8*)(vb + vq0 + (i & 3) * 32 * AT_VP + (((2 * (i >> 2)) ^ vsw) << 4));
                o[i & 3] = __builtin_amdgcn_mfma_f32_32x32x16_bf16(vf, __builtin_bit_cast(bf16x8, i < 4 ? wp0 : wp1), o[i & 3], 0, 0, 0); } }
    }
#undef AT_DMA
    bf16* op = Ob + (size_t)t * DM + h * HD + 4 * hh;
#pragma unroll
    for (int db = 0; db < 4; ++db)
#pragma unroll
        for (int r4 = 0; r4 < 4; ++r4) { const unsigned long long pk = (unsigned long long)cvtpk(o[db][4 * r4 + 0], o[db][4 * r4 + 1]) | ((unsigned long long)cvtpk(o[db][4 * r4 + 2], o[db][4 * r4 + 3]) << 32);
            *(unsigned long long*)(op + 32 * db + 8 * r4) = pk; }
}
__device__ __forceinline__ void attn_prompt_phase(const Ctx& C) {
    KArgs A = kargs(); unsigned char* ws = A->ws; const float* sb_bias = INP(float, 23);
    const bf16* Kb = WSP(bf16, WS_KB); const bf16* Vt = WSP(bf16, WS_VT); const bf16* Qb = WSP(bf16, WS_QB); bf16* Ob = WSP(bf16, WS_OB);
    const int vcu = (C.G % 8 == 0) ? (C.bx % 8) * (C.G / 8) + C.bx / 8 : C.bx;
    for (int pi = vcu; pi < 256; pi += C.G) {
        const int kvh = pi >> 6, s = pi & 63;
        attn_prompt_unit(C, Qb, Kb, Vt, Ob, sb_bias, kvh, 127 - s);
        attn_prompt_unit(C, Qb, Kb, Vt, Ob, sb_bias, kvh, s);
    }
}


constexpr int SA_KP = 272, SA_VP = 80, SA_WAVE = 10240, SA_TS_OFF = 8 * SA_WAVE, SA_Q_OFF = SA_TS_OFF + 1024;
static_assert(32 * SA_KP <= SA_WAVE && 128 * SA_VP <= SA_WAVE && SA_Q_OFF + 32 * SA_KP <= RING_BYTES && 4 * 16384 <= SA_TS_OFF, "sample attention LDS");
__device__ __forceinline__ void attn_sample_unit(const Ctx& C, KArgs A, int b, int kvh) {
    unsigned char* ws = A->ws; float* out = A->out;
    const float* cache_k = INP(float, 6); const float* cache_v = INP(float, 7); const int* page_table = INP(int, 8); const float* sb_bias = INP(float, 23);
    const bf16* Qb = WSP(bf16, WS_QB); bf16* Ob = WSP(bf16, WS_OB);
    LAS unsigned char* const L = C.L; const int lane = C.lane, wave = C.wave;
    const int r32 = lane & 31, hh = lane >> 5, g = r32 >> 3, t = r32 & 7, h = kvh * 4 + g, row = TP + b * DECT + t;
    const int dl = lane & 31, par = lane >> 5;
    LAS unsigned char* const QT = L + SA_Q_OFF;
    { const int col = C.tid >> 4, ch = C.tid & 15; const v4u qv = *(const v4u*)(Qb + (size_t)(TP + b * DECT + (col & 7)) * DM + (kvh * 4 + (col >> 3)) * HD + ch * 8);
      *(LAS v4u*)(QT + col * SA_KP + ch * 16) = qv; }
    __syncthreads();
    const float bias2 = sb_bias[h] * LOG2E;
    bf16x8 tri[2];
#pragma unroll
    for (int s = 0; s < 2; ++s)
#pragma unroll
        for (int jj = 0; jj < 8; ++jj) { const int key = 16 * s + 8 * (jj >> 2) + 4 * hh + (jj & 3); tri[s][jj] = (key >= r32) ? (short)0x3F80 : (short)0; }
    f32x16 o[4];
#pragma unroll
    for (int db = 0; db < 4; ++db)
#pragma unroll
        for (int r = 0; r < 16; ++r) o[db][r] = 0.f;
    float R = 0.f;
    LAS unsigned char* const T = L + wave * SA_WAVE;
    f32x4 st[16];
    const int nblk = (wave == 7) ? 9 : 8;
#define SA_BASE(bi_, ptr_, cache_, newp_, isnew_) do { int kb_ = 7 - ((bi_) - (nblk - 8)); isnew_ = (kb_ > 7); if (isnew_) { ptr_ = (newp_) + ((size_t)b * DECT * NKV + kvh) * HD; } \
        else { const int pg_ = page_table[b * NPG + 2 * wave + (kb_ >> 2)]; ptr_ = (cache_) + (((size_t)pg_ * 128 + 32 * (kb_ & 3)) * NKV + kvh) * HD; } } while (0)
#define SA_UNI(p_) ((const char*)(uintptr_t)(((unsigned long long)(unsigned)__builtin_amdgcn_readfirstlane((int)((unsigned long long)(uintptr_t)(p_) >> 32)) << 32) | (unsigned)__builtin_amdgcn_readfirstlane((int)(unsigned)(unsigned long long)(uintptr_t)(p_))))
#define SA_LOADK(ptr_, isnew_) do { const char* ub_ = SA_UNI(ptr_); _Pragma("unroll") for (int q_ = 0; q_ < 16; ++q_) { \
        if (!(isnew_) || q_ < 4) st[q_] = __builtin_nontemporal_load((const f32x4*)(ub_ + q_ * 4096 + koff)); else st[q_] = (f32x4){0.f, 0.f, 0.f, 0.f}; } } while (0)
#define SA_LOADV(ptr_, isnew_) do { const char* ub_ = SA_UNI(ptr_); _Pragma("unroll") for (int q_ = 0; q_ < 16; ++q_) { \
        if (!(isnew_) || q_ < 4) st[q_] = __builtin_nontemporal_load((const f32x4*)(ub_ + (8 * (q_ >> 2) + (q_ & 3)) * 2048 + voff)); else st[q_] = (f32x4){0.f, 0.f, 0.f, 0.f}; } } while (0)
    const unsigned koff = (unsigned)(par * 2048 + dl * 16), voff = (unsigned)(par * 8192 + dl * 16);
    const float* kptr; const float* vptr; bool isnew;
    SA_BASE(0, kptr, cache_k, out + O_K_S, isnew);
    SA_LOADK(kptr, isnew);
    for (int bi = 0; bi < nblk; ++bi) {
#pragma unroll
        for (int q = 0; q < 16; ++q) { const unsigned long long pk = (unsigned long long)cvtpk(st[q].x, st[q].y) | ((unsigned long long)cvtpk(st[q].z, st[q].w) << 32);
            *(LAS unsigned long long*)(T + (2 * q + par) * SA_KP + dl * 8) = pk; }
        SA_BASE(bi, vptr, cache_v, out + O_V_S, isnew);
        SA_LOADV(vptr, isnew);
        f32x16 z;
#pragma unroll
        for (int r = 0; r < 16; ++r) z[r] = bias2;
#pragma unroll
        for (int ks = 0; ks < 8; ++ks) { const bf16x8 kf = *(const LAS bf16x8*)(T + r32 * SA_KP + (16 * ks + 8 * hh) * 2); const bf16x8 qq = *(const LAS bf16x8*)(QT + r32 * SA_KP + (16 * ks + 8 * hh) * 2); z = __builtin_amdgcn_mfma_f32_32x32x16_bf16(kf, qq, z, 0, 0, 0); }
        if (isnew) {
#pragma unroll
            for (int r = 0; r < 16; ++r) { const int kk = (r & 3) + 8 * (r >> 2) + 4 * hh; if (kk >= t) z[r] = -INFINITY; } }
        f32x16 sp;
#pragma unroll
        for (int r = 0; r < 16; ++r) sp[r] = __builtin_amdgcn_logf(1.f + __builtin_amdgcn_exp2f(z[r]));
        const bf16x8 sp0 = pack8(sp, 0), sp1 = pack8(sp, 1);
        f32x16 cum;
#pragma unroll
        for (int r = 0; r < 16; ++r) cum[r] = R;
        cum = __builtin_amdgcn_mfma_f32_32x32x16_bf16(tri[0], sp0, cum, 0, 0, 0);
        cum = __builtin_amdgcn_mfma_f32_32x32x16_bf16(tri[1], sp1, cum, 0, 0, 0);
#pragma unroll
        for (int r = 0; r < 16; ++r) sp[r] = __builtin_amdgcn_exp2f(z[r] - cum[r]);
        const bf16x8 w0 = pack8(sp, 0), w1 = pack8(sp, 1);
#pragma unroll
        for (int q4 = 0; q4 < 4; ++q4)
#pragma unroll
            for (int e = 0; e < 4; ++e) { const unsigned long long pk = (unsigned long long)cvtpk(st[q4 * 4 + 0][e], st[q4 * 4 + 1][e]) | ((unsigned long long)cvtpk(st[q4 * 4 + 2][e], st[q4 * 4 + 3][e]) << 32);
                *(LAS unsigned long long*)(T + (4 * dl + e) * SA_VP + (16 * (q4 >> 1) + 8 * par + 4 * (q4 & 1)) * 2) = pk; }
        if (bi + 1 < nblk) { SA_BASE(bi + 1, kptr, cache_k, out + O_K_S, isnew); SA_LOADK(kptr, isnew); }
#pragma unroll
        for (int db = 0; db < 4; ++db) {
            const bf16x8 v0 = *(const LAS bf16x8*)(T + (32 * db + r32) * SA_VP + (8 * hh) * 2);
            const bf16x8 v1 = *(const LAS bf16x8*)(T + (32 * db + r32) * SA_VP + (16 + 8 * hh) * 2);
            o[db] = __builtin_amdgcn_mfma_f32_32x32x16_bf16(v0, w0, o[db], 0, 0, 0);
            o[db] = __builtin_amdgcn_mfma_f32_32x32x16_bf16(v1, w1, o[db], 0, 0, 0); }
        R = __shfl(cum[0], r32);
    }
#undef SA_BASE
#undef SA_LOADK
#undef SA_LOADV
#undef SA_UNI
    LAS float* TS = (LAS float*)(L + SA_TS_OFF);
    if (hh == 0) TS[wave * 32 + r32] = R;
    __syncthreads();
    float later = 0.f;
    for (int w2 = wave + 1; w2 < 8; ++w2) later += TS[w2 * 32 + r32];
    const float fsc = __builtin_amdgcn_exp2f(-later);
#pragma unroll
    for (int db = 0; db < 4; ++db)
#pragma unroll
        for (int r = 0; r < 16; ++r) o[db][r] *= fsc;
#pragma unroll
    for (int rd = 0; rd < 3; ++rd) { const int half = 4 >> rd;
        if (wave >= half && wave < 2 * half) { LAS float* S = (LAS float*)(L + (wave - half) * 16384);
#pragma unroll
            for (int db = 0; db < 4; ++db)
#pragma unroll
                for (int r = 0; r < 16; ++r) S[(db * 16 + r) * 64 + lane] = o[db][r]; }
        __syncthreads();
        if (wave < half) { const LAS float* S = (const LAS float*)(L + wave * 16384);
#pragma unroll
            for (int db = 0; db < 4; ++db)
#pragma unroll
                for (int r = 0; r < 16; ++r) o[db][r] += S[(db * 16 + r) * 64 + lane]; }
        __syncthreads();
    }
    if (wave == 0) { bf16* op = Ob + (size_t)row * DM + h * HD + 4 * hh;
#pragma unroll
        for (int db = 0; db < 4; ++db)
#pragma unroll
            for (int r4 = 0; r4 < 4; ++r4) { const unsigned long long pk = (unsigned long long)cvtpk(o[db][4 * r4 + 0], o[db][4 * r4 + 1]) | ((unsigned long long)cvtpk(o[db][4 * r4 + 2], o[db][4 * r4 + 3]) << 32);
                *(unsigned long long*)(op + 32 * db + 8 * r4) = pk; } }
}
constexpr int SB_PAIR = 20480, SB_VOFF = 10240;
static_assert(32 * SA_KP <= SB_VOFF && SB_VOFF + 128 * SA_VP <= SB_PAIR && 4 * SB_PAIR <= SA_TS_OFF, "specialised sample attention LDS");
#define SB_POLL(flag_, need_) do { unsigned sp_ = 0u; while ((unsigned)__builtin_amdgcn_readfirstlane((int)*(flag_)) < (unsigned)(need_)) { __builtin_amdgcn_s_sleep(1); if (++sp_ > (1u << 22)) break; } asm volatile("" ::: "memory"); } while (0)
__device__ __forceinline__ void attn_sample_unit2(const Ctx& C, KArgs A, int b, int kvh) {
    unsigned char* ws = A->ws; float* out = A->out;
    const float* cache_k = INP(float, 6); const float* cache_v = INP(float, 7); const int* page_table = INP(int, 8); const float* sb_bias = INP(float, 23);
    const bf16* Qb = WSP(bf16, WS_QB); bf16* Ob = WSP(bf16, WS_OB);
    LAS unsigned char* const L = C.L; int lane = C.lane, tid = C.tid; const int wave = C.wave;
    asm volatile("" : "+v"(lane), "+v"(tid));
    const int r32 = lane & 31, hh = lane >> 5, g = r32 >> 3, t = r32 & 7, h = kvh * 4 + g, row = TP + b * DECT + t;
    const int dl = lane & 31, par = lane >> 5;
    const int pw = wave & 3;
    LAS unsigned char* const QT = L + SA_Q_OFF;
    volatile LAS unsigned* const FL = (volatile LAS unsigned*)(L + MISC_OFF) + 32 + 4 * pw;
    { const int col = tid >> 4, ch = tid & 15; const v4u qv = *(const v4u*)(Qb + (size_t)(TP + b * DECT + (col & 7)) * DM + (kvh * 4 + (col >> 3)) * HD + ch * 8);
      *(LAS v4u*)(QT + col * SA_KP + ch * 16) = qv; }
    if (tid < 16) ((volatile LAS unsigned*)(L + MISC_OFF) + 32)[tid] = 0u;
    __syncthreads();
    LAS unsigned char* const TK = L + pw * SB_PAIR; LAS unsigned char* const TV = TK + SB_VOFF;
    const int nblk = (pw == 3) ? 17 : 16;
    if (wave >= 4) {
        f32x4 sA[8], sB[8], sC[8], sD[8], sE[8];
        int pgs[4];
#pragma unroll
        for (int k_ = 0; k_ < 4; ++k_) pgs[k_] = __builtin_amdgcn_readfirstlane(page_table[b * NPG + 4 * pw + k_]);
        const unsigned koff = (unsigned)(par * 2048 + dl * 16), voff = (unsigned)(par * 8192 + dl * 16);
#define SB_UNI(p_) ((const char*)(uintptr_t)(((unsigned long long)(unsigned)__builtin_amdgcn_readfirstlane((int)((unsigned long long)(uintptr_t)(p_) >> 32)) << 32) | (unsigned)__builtin_amdgcn_readfirstlane((int)(unsigned)(unsigned long long)(uintptr_t)(p_))))
#define SB_ISSUE(st_, t_) do { constexpr int bi_ = (t_) >> 2, KIND_ = ((t_) >> 1) & 1, hf_ = (t_) & 1; const int kb_ = 15 - (bi_ - (nblk - 16)); const bool nw_ = (bi_ == 0) && (kb_ > 15); const float* p_; \
        if (nw_) p_ = (KIND_ ? out + O_V_S : out + O_K_S) + ((size_t)b * DECT * NKV + kvh) * HD; \
        else { const int pg_ = (nblk == 17) ? pgs[((16 - bi_) & 15) >> 2] : pgs[((15 - bi_) & 15) >> 2]; p_ = (KIND_ ? cache_v : cache_k) + (((size_t)pg_ * 128 + 32 * (kb_ & 3)) * NKV + kvh) * HD; } \
        const __amdgpu_buffer_rsrc_t rs_ = __builtin_amdgcn_make_buffer_rsrc((void*)SB_UNI(p_), (short)0, 0x7fffffff, 0x00020000); const int qm_ = nw_ ? 3 : 15; \
        _Pragma("unroll") for (int q_ = 0; q_ < 8; ++q_) { const int qq_ = (q_ + 8 * hf_) & qm_; \
            st_[q_] = __builtin_bit_cast(f32x4, __builtin_amdgcn_raw_buffer_load_b128(rs_, (int)(KIND_ ? voff : koff), KIND_ ? (8 * (qq_ >> 2) + (qq_ & 3)) * 2048 : qq_ * 4096, 2)); } } while (0)
#define SB_EMIT(st_, t_) do { constexpr int bi_ = (t_) >> 2, KIND_ = ((t_) >> 1) & 1, hf_ = (t_) & 1; \
        if (bi_ == 0) { if (nblk == 17) { _Pragma("unroll") for (int q_ = 0; q_ < 8; ++q_) if (q_ + 8 * hf_ >= 4) st_[q_] = (f32x4){0.f, 0.f, 0.f, 0.f}; } } \
        if (KIND_) { if (hf_ == 0) SB_POLL(FL + 3, bi_); \
            _Pragma("unroll") for (int q4_ = 0; q4_ < 2; ++q4_) _Pragma("unroll") for (int e_ = 0; e_ < 4; ++e_) { \
                const unsigned long long pk_ = (unsigned long long)cvtpk(st_[q4_ * 4 + 0][e_], st_[q4_ * 4 + 1][e_]) | ((unsigned long long)cvtpk(st_[q4_ * 4 + 2][e_], st_[q4_ * 4 + 3][e_]) << 32); \
                *(LAS unsigned long long*)(TV + (4 * dl + e_) * SA_VP + (16 * hf_ + 8 * par + 4 * q4_) * 2) = pk_; } \
            asm volatile("" ::: "memory"); FL[2] = (unsigned)(2 * bi_ + hf_ + 1); } \
        else { if (hf_ == 0) SB_POLL(FL + 1, bi_); \
            _Pragma("unroll") for (int q_ = 0; q_ < 8; ++q_) { const unsigned long long pk_ = (unsigned long long)cvtpk(st_[q_].x, st_[q_].y) | ((unsigned long long)cvtpk(st_[q_].z, st_[q_].w) << 32); \
                *(LAS unsigned long long*)(TK + (2 * (q_ + 8 * hf_) + par) * SA_KP + dl * 8) = pk_; } \
            asm volatile("" ::: "memory"); FL[0] = (unsigned)(2 * bi_ + hf_ + 1); } } while (0)
#define SB_E(st_, t_) SB_EMIT(st_, t_)
#define SB_I(st_, t_) SB_ISSUE(st_, t_)
        SB_I(sA, 0); SB_I(sB, 1); SB_I(sC, 2); SB_I(sD, 3); SB_I(sE, 4);
        SB_E(sA, 0); SB_I(sA, 5);
        SB_E(sB, 1); SB_I(sB, 6);
        SB_E(sC, 2); SB_I(sC, 7);
        SB_E(sD, 3); SB_I(sD, 8);
        SB_E(sE, 4); SB_I(sE, 9);
        SB_E(sA, 5); SB_I(sA, 10);
        SB_E(sB, 6); SB_I(sB, 11);
        SB_E(sC, 7); SB_I(sC, 12);
        SB_E(sD, 8); SB_I(sD, 13);
        SB_E(sE, 9); SB_I(sE, 14);
        SB_E(sA, 10); SB_I(sA, 15);
        SB_E(sB, 11); SB_I(sB, 16);
        SB_E(sC, 12); SB_I(sC, 17);
        SB_E(sD, 13); SB_I(sD, 18);
        SB_E(sE, 14); SB_I(sE, 19);
        SB_E(sA, 15); SB_I(sA, 20);
        SB_E(sB, 16); SB_I(sB, 21);
        SB_E(sC, 17); SB_I(sC, 22);
        SB_E(sD, 18); SB_I(sD, 23);
        SB_E(sE, 19); SB_I(sE, 24);
        SB_E(sA, 20); SB_I(sA, 25);
        SB_E(sB, 21); SB_I(sB, 26);
        SB_E(sC, 22); SB_I(sC, 27);
        SB_E(sD, 23); SB_I(sD, 28);
        SB_E(sE, 24); SB_I(sE, 29);
        SB_E(sA, 25); SB_I(sA, 30);
        SB_E(sB, 26); SB_I(sB, 31);
        SB_E(sC, 27); SB_I(sC, 32);
        SB_E(sD, 28); SB_I(sD, 33);
        SB_E(sE, 29); SB_I(sE, 34);
        SB_E(sA, 30); SB_I(sA, 35);
        SB_E(sB, 31); SB_I(sB, 36);
        SB_E(sC, 32); SB_I(sC, 37);
        SB_E(sD, 33); SB_I(sD, 38);
        SB_E(sE, 34); SB_I(sE, 39);
        SB_E(sA, 35); SB_I(sA, 40);
        SB_E(sB, 36); SB_I(sB, 41);
        SB_E(sC, 37); SB_I(sC, 42);
        SB_E(sD, 38); SB_I(sD, 43);
        SB_E(sE, 39); SB_I(sE, 44);
        SB_E(sA, 40); SB_I(sA, 45);
        SB_E(sB, 41); SB_I(sB, 46);
        SB_E(sC, 42); SB_I(sC, 47);
        SB_E(sD, 43); SB_I(sD, 48);
        SB_E(sE, 44); SB_I(sE, 49);
        SB_E(sA, 45); SB_I(sA, 50);
        SB_E(sB, 46); SB_I(sB, 51);
        SB_E(sC, 47); SB_I(sC, 52);
        SB_E(sD, 48); SB_I(sD, 53);
        SB_E(sE, 49); SB_I(sE, 54);
        SB_E(sA, 50); SB_I(sA, 55);
        SB_E(sB, 51); SB_I(sB, 56);
        SB_E(sC, 52); SB_I(sC, 57);
        SB_E(sD, 53); SB_I(sD, 58);
        SB_E(sE, 54); SB_I(sE, 59);
        SB_E(sA, 55); SB_I(sA, 60);
        SB_E(sB, 56); SB_I(sB, 61);
        SB_E(sC, 57); SB_I(sC, 62);
        SB_E(sD, 58); SB_I(sD, 63);
        SB_E(sE, 59); if (pw == 3) { SB_I(sE, 64); }
        SB_E(sA, 60); if (pw == 3) { SB_I(sA, 65); }
        SB_E(sB, 61); if (pw == 3) { SB_I(sB, 66); }
        SB_E(sC, 62); if (pw == 3) { SB_I(sC, 67); }
        SB_E(sD, 63);
        if (pw == 3) { SB_E(sE, 64); }
        if (pw == 3) { SB_E(sA, 65); }
        if (pw == 3) { SB_E(sB, 66); }
        if (pw == 3) { SB_E(sC, 67); }
#undef SB_E
#undef SB_I
#undef SB_UNI
#undef SB_ISSUE
#undef SB_EMIT
        __syncthreads(); __syncthreads(); __syncthreads(); __syncthreads(); __syncthreads(); __syncthreads();
    } else {
        f32x16 o[4];
#pragma unroll
        for (int db = 0; db < 4; ++db)
#pragma unroll
            for (int r = 0; r < 16; ++r) o[db][r] = 0.f;
        float R = 0.f;
        const float bias2 = sb_bias[h] * LOG2E;
        bf16x8 tri[2];
#pragma unroll
        for (int s_ = 0; s_ < 2; ++s_)
#pragma unroll
            for (int jj = 0; jj < 8; ++jj) { const int key = 16 * s_ + 8 * (jj >> 2) + 4 * hh + (jj & 3); tri[s_][jj] = (key >= r32) ? (short)0x3F80 : (short)0; }
        for (int bi = 0; bi < nblk; ++bi) {
            const bool isnew = (pw == 3) && (bi == 0);
            SB_POLL(FL + 0, 2 * (bi + 1));
            bf16x8 kf[8];
#pragma unroll
            for (int ks = 0; ks < 8; ++ks) kf[ks] = *(const LAS bf16x8*)(TK + r32 * SA_KP + (16 * ks + 8 * hh) * 2);
            asm volatile("s_waitcnt lgkmcnt(0)" ::: "memory");
            FL[1] = (unsigned)(bi + 1);
            f32x16 z;
#pragma unroll
            for (int r = 0; r < 16; ++r) z[r] = bias2;
#pragma unroll
            for (int ks = 0; ks < 8; ++ks) { const bf16x8 qq = *(const LAS bf16x8*)(QT + r32 * SA_KP + (16 * ks + 8 * hh) * 2); z = __builtin_amdgcn_mfma_f32_32x32x16_bf16(kf[ks], qq, z, 0, 0, 0); }
            if (isnew) {
#pragma unroll
                for (int r = 0; r < 16; ++r) { const int kk = (r & 3) + 8 * (r >> 2) + 4 * hh; if (kk >= t) z[r] = -INFINITY; } }
            f32x16 sp;
#pragma unroll
            for (int r = 0; r < 16; ++r) sp[r] = __builtin_amdgcn_logf(1.f + __builtin_amdgcn_exp2f(z[r]));
            const bf16x8 sp0 = pack8(sp, 0), sp1 = pack8(sp, 1);
            f32x16 cum;
#pragma unroll
            for (int r = 0; r < 16; ++r) cum[r] = R;
            cum = __builtin_amdgcn_mfma_f32_32x32x16_bf16(tri[0], sp0, cum, 0, 0, 0);
            cum = __builtin_amdgcn_mfma_f32_32x32x16_bf16(tri[1], sp1, cum, 0, 0, 0);
#pragma unroll
            for (int r = 0; r < 16; ++r) sp[r] = __builtin_amdgcn_exp2f(z[r] - cum[r]);
            const bf16x8 w0 = pack8(sp, 0), w1 = pack8(sp, 1);
            SB_POLL(FL + 2, 2 * (bi + 1));
#pragma unroll
            for (int db = 0; db < 4; ++db) {
                const bf16x8 v0 = *(const LAS bf16x8*)(TV + (32 * db + r32) * SA_VP + (8 * hh) * 2);
                const bf16x8 v1 = *(const LAS bf16x8*)(TV + (32 * db + r32) * SA_VP + (16 + 8 * hh) * 2);
                o[db] = __builtin_amdgcn_mfma_f32_32x32x16_bf16(v0, w0, o[db], 0, 0, 0);
                o[db] = __builtin_amdgcn_mfma_f32_32x32x16_bf16(v1, w1, o[db], 0, 0, 0); }
            asm volatile("s_waitcnt lgkmcnt(0)" ::: "memory");
            FL[3] = (unsigned)(bi + 1);
            R = __shfl(cum[0], r32);
        }
    LAS float* TS = (LAS float*)(L + SA_TS_OFF);
    __syncthreads();
    if (hh == 0) TS[wave * 32 + r32] = R;
    __syncthreads();
    {
        float later = 0.f;
        for (int w2 = wave + 1; w2 < 4; ++w2) later += TS[w2 * 32 + r32];
        const float fsc = __builtin_amdgcn_exp2f(-later);
#pragma unroll
        for (int db = 0; db < 4; ++db)
#pragma unroll
            for (int r = 0; r < 16; ++r) o[db][r] *= fsc;
    }
#pragma unroll
    for (int rd = 0; rd < 2; ++rd) { const int half = 2 >> rd;
        if (wave >= half && wave < 2 * half) { LAS float* S = (LAS float*)(L + (wave - half) * 16384);
#pragma unroll
            for (int db = 0; db < 4; ++db)
#pragma unroll
                for (int r = 0; r < 16; ++r) S[(db * 16 + r) * 64 + lane] = o[db][r]; }
        __syncthreads();
        if (wave < half) { const LAS float* S = (const LAS float*)(L + wave * 16384);
#pragma unroll
            for (int db = 0; db < 4; ++db)
#pragma unroll
                for (int r = 0; r < 16; ++r) o[db][r] += S[(db * 16 + r) * 64 + lane]; }
        __syncthreads();
    }
    if (wave == 0) { bf16* op = Ob + (size_t)row * DM + h * HD + 4 * hh;
#pragma unroll
        for (int db = 0; db < 4; ++db)
#pragma unroll
            for (int r4 = 0; r4 < 4; ++r4) { const unsigned long long pk = (unsigned long long)cvtpk(o[db][4 * r4 + 0], o[db][4 * r4 + 1]) | ((unsigned long long)cvtpk(o[db][4 * r4 + 2], o[db][4 * r4 + 3]) << 32);
                *(unsigned long long*)(op + 32 * db + 8 * r4) = pk; } }
    }
}
__device__ __forceinline__ void attn_sample_phase(const Ctx& C) {
    KArgs A = kargs();
    const int vcu = (C.G % 8 == 0) ? (C.bx % 8) * (C.G / 8) + C.bx / 8 : C.bx;
    for (int u = vcu; u < DECB * NKV; u += C.G) attn_sample_unit(C, A, u >> 2, u & 3);
}


__device__ __forceinline__ void attn_drain_sample(const Ctx& C) {
    KArgs A = kargs(); unsigned char* ws = A->ws;
    unsigned* head_s = (unsigned*)(ws + WS_CTL) + CW_ATQ + 64 * 4;
    volatile LAS unsigned* slot = (volatile LAS unsigned*)(C.L + MISC_OFF) + 16;
    for (;;) {
        __syncthreads();
        if (C.tid == 0) *slot = __hip_atomic_fetch_add(head_s, 1u, __ATOMIC_RELAXED, __HIP_MEMORY_SCOPE_AGENT);
        __syncthreads();
        const unsigned idx = *slot;
        if (idx >= (unsigned)(DECB * NKV)) break;
        attn_sample_unit2(C, A, (int)(idx >> 2), (int)(idx & 3));
    }
}
__device__ __forceinline__ void attn_drain_prompt(const Ctx& C) {
    KArgs A = kargs(); unsigned char* ws = A->ws; const float* sb_bias = INP(float, 23);
    const bf16* Kb = WSP(bf16, WS_KB); const bf16* Vt = WSP(bf16, WS_VT); const bf16* Qb = WSP(bf16, WS_QB); bf16* Ob = WSP(bf16, WS_OB);
    const int g = (C.bx & 7) >> 1;
    unsigned* head_p = (unsigned*)(ws + WS_CTL) + CW_ATQ + 64 * g;
    volatile LAS unsigned* slot = (volatile LAS unsigned*)(C.L + MISC_OFF) + 16;
    for (;;) {
        __syncthreads();
        if (C.tid == 0) *slot = __hip_atomic_fetch_add(head_p, 1u, __ATOMIC_RELAXED, __HIP_MEMORY_SCOPE_AGENT);
        __syncthreads();
        const unsigned idx = *slot;
        if (idx >= 128u) break;
        attn_prompt_unit(C, Qb, Kb, Vt, Ob, sb_bias, g, 127 - (int)idx);
    }
}
__device__ __forceinline__ void attn_phase_dealt(const Ctx& C) {
    if ((C.bx >> 3) >= AT_SMP_R0) { attn_drain_sample(C); attn_drain_prompt(C); } else { attn_drain_prompt(C); attn_drain_sample(C); }
}


constexpr int SG_P = 272, SG_ABYTES = 128 * SG_P, SG_BBYTES = 64 * SG_P, SG_BUF = SG_ABYTES + SG_BBYTES;
static_assert(2 * SG_BUF <= RING_BYTES, "small GEMM LDS");
struct SEmitGate { static constexpr bool NEEDS = false, STATS = false; const bf16* Gm; bf16* O; const float* stp; float* stn; __device__ __forceinline__ f32x4 operator()(int row, int col, f32x4 v, float, float) const { const size_t o = (size_t)row * DM + col; const unsigned long long gq = *(const unsigned long long*)(Gm + o); const unsigned g0 = (unsigned)gq, g1 = (unsigned)(gq >> 32);
    *(unsigned long long*)(O + o) = (unsigned long long)cvtpk(bflo(g0) * pg8::sigm(v[0]), bfhi(g0) * pg8::sigm(v[1])) | ((unsigned long long)cvtpk(bflo(g1) * pg8::sigm(v[2]), bfhi(g1) * pg8::sigm(v[3])) << 32); return v; } };
template <int ACT> struct SEmitAct { static constexpr bool NEEDS = (ACT == 1), STATS = false; bf16* O; int ldc; const float* stp; const float* c1; const float* c2; float* stn; __device__ __forceinline__ f32x4 operator()(int row, int col, f32x4 v, float mu, float rstd) const {
    if (ACT == 1) { const f32x4 a4 = *(const f32x4*)(c1 + col), d4 = *(const f32x4*)(c2 + col); v = (v - a4 * mu) * rstd + d4;
#pragma unroll
        for (int i = 0; i < 4; ++i) { const float a = fmaxf(v[i], 0.f); v[i] = a * a; } }
    *(unsigned long long*)(O + (size_t)row * ldc + col) = (unsigned long long)cvtpk(v[0], v[1]) | ((unsigned long long)cvtpk(v[2], v[3]) << 32); return v; } };
struct SEmitRes { static constexpr bool NEEDS = true, STATS = true; const float* X; const bf16* Xb; const float* stp; const float* gp; const float* bp; float* R; bf16* Rb; float* stn; __device__ __forceinline__ f32x4 operator()(int row, int col, f32x4 v, float mu, float rstd) const { const size_t o = (size_t)row * DM + col; f32x4 x;
    if (stp) { const unsigned long long xq = *(const unsigned long long*)(Xb + o); const unsigned x0 = (unsigned)xq, x1 = (unsigned)(xq >> 32); x = (f32x4){bflo(x0), bfhi(x0), bflo(x1), bfhi(x1)}; const f32x4 g4 = *(const f32x4*)(gp + col), b4 = *(const f32x4*)(bp + col); x = (x - mu) * rstd * g4 + b4; } else x = *(const f32x4*)(X + o);
    const f32x4 r = x * DN_ALPHA + v; if (R) *(f32x4*)(R + o) = r; *(unsigned long long*)(Rb + o) = (unsigned long long)cvtpk(r[0], r[1]) | ((unsigned long long)cvtpk(r[2], r[3]) << 32); return r; } };
struct SEmitPle { static constexpr bool NEEDS = true, STATS = true; const bf16* X; const bf16* E; const float* stp; const float* gp; const float* bp; const float* c1; const float* c2; float* R; bf16* Rb; float* stn; __device__ __forceinline__ f32x4 operator()(int row, int col, f32x4 acc, float mu, float rstd) const { const size_t o = (size_t)row * DM + col; const unsigned long long xq = *(const unsigned long long*)(X + o); const unsigned x0 = (unsigned)xq, x1 = (unsigned)(xq >> 32); f32x4 x = {bflo(x0), bfhi(x0), bflo(x1), bfhi(x1)};
    const f32x4 g4 = *(const f32x4*)(gp + col), b4 = *(const f32x4*)(bp + col), a4 = *(const f32x4*)(c1 + col), d4 = *(const f32x4*)(c2 + col);
    x = (x - mu) * rstd * g4 + b4; const f32x4 v = (acc - a4 * mu) * rstd + d4;
    const unsigned long long eq = *(const unsigned long long*)(E + o); const unsigned e0 = (unsigned)eq, e1 = (unsigned)(eq >> 32);
    f32x4 r; r[0] = x[0] * DN_ALPHA + bflo(e0) * pg8::sigm(v[0]); r[1] = x[1] * DN_ALPHA + bfhi(e0) * pg8::sigm(v[1]); r[2] = x[2] * DN_ALPHA + bflo(e1) * pg8::sigm(v[2]); r[3] = x[3] * DN_ALPHA + bfhi(e1) * pg8::sigm(v[3]);
    if (R) *(f32x4*)(R + o) = r; if (Rb) *(unsigned long long*)(Rb + o) = (unsigned long long)cvtpk(r[0], r[1]) | ((unsigned long long)cvtpk(r[2], r[3]) << 32); return r; } };
struct SEmitKVQ { static constexpr bool NEEDS = true, STATS = false; float* ks; float* vs; bf16* Qb; const float* stp; const float* c1; const float* c2; float* stn; __device__ __forceinline__ f32x4 operator()(int row, int col, f32x4 acc, float mu, float rstd) const {
    const f32x4 a4 = *(const f32x4*)(c1 + col), d4 = *(const f32x4*)(c2 + col); const f32x4 v = (acc - a4 * mu) * rstd + d4;
    if (col < 512) *(f32x4*)(ks + (size_t)(row - TP) * 512 + col) = v;
    else if (col < 1024) *(f32x4*)(vs + (size_t)(row - TP) * 512 + (col - 512)) = v;
    else { const f32x4 q = v * QSCALE; *(unsigned long long*)(Qb + (size_t)row * DM + (col - 1024)) = (unsigned long long)cvtpk(q[0], q[1]) | ((unsigned long long)cvtpk(q[2], q[3]) << 32); } return v; } };
template <class Emit> __device__ __forceinline__ void small_gemm(const Ctx& C, const bf16* Ag, const bf16* Bt, int N, int K, int first, int stride, const Emit& E) {
    LAS unsigned char* const L = C.L; const int tid = C.tid, lane = C.lane, wave = C.wave;
    const int r32 = lane & 31, hh = lane >> 5, wm = wave >> 1, wn = wave & 1;
    const int nN = N / 64, nunits = (NSMP / 128) * nN, nkt = K / 128;
    const int prow = tid >> 4, pch = tid & 15;
    for (int u = first; u < nunits; u += stride) {
        const int mt = u / nN, nt = u - mt * nN; const int row0 = TP + mt * 128, n0 = nt * 64;
        const bf16* ag = Ag + (size_t)(row0 + prow) * K + pch * 8; const bf16* bg = Bt + (size_t)(n0 + prow) * K + pch * 8;
        v4u sa0[4], sb0[2], sa1[4], sb1[2];
#define SG_LOAD(sa_, sb_, kt_) do { _Pragma("unroll") for (int i_ = 0; i_ < 4; ++i_) sa_[i_] = *(const v4u*)(ag + (size_t)(32 * i_) * K + (kt_) * 128); \
        _Pragma("unroll") for (int i_ = 0; i_ < 2; ++i_) sb_[i_] = *(const v4u*)(bg + (size_t)(32 * i_) * K + (kt_) * 128); } while (0)
#define SG_STORE(buf_, sa_, sb_) do { LAS unsigned char* B_ = L + (buf_) * SG_BUF; _Pragma("unroll") for (int i_ = 0; i_ < 4; ++i_) *(LAS v4u*)(B_ + (prow + 32 * i_) * SG_P + pch * 16) = sa_[i_]; \
        _Pragma("unroll") for (int i_ = 0; i_ < 2; ++i_) *(LAS v4u*)(B_ + SG_ABYTES + (prow + 32 * i_) * SG_P + pch * 16) = sb_[i_]; } while (0)
#define SG_SYNC() do { asm volatile("s_waitcnt lgkmcnt(0)" ::: "memory"); __builtin_amdgcn_s_barrier(); asm volatile("" ::: "memory"); } while (0)
#define SG_MMA(buf_) do { const LAS unsigned char* AB_ = L + (buf_) * SG_BUF + (32 * wm + r32) * SG_P + 16 * hh; const LAS unsigned char* BB_ = L + (buf_) * SG_BUF + SG_ABYTES + (32 * wn + r32) * SG_P + 16 * hh; \
        _Pragma("unroll") for (int ks = 0; ks < 8; ++ks) { const bf16x8 wf = *(const LAS bf16x8*)(BB_ + 32 * ks); const bf16x8 af = *(const LAS bf16x8*)(AB_ + 32 * ks); acc = __builtin_amdgcn_mfma_f32_32x32x16_bf16(wf, af, acc, 0, 0, 0); } } while (0)
        f32x16 acc;
#pragma unroll
        for (int r = 0; r < 16; ++r) acc[r] = 0.f;
        SG_LOAD(sa0, sb0, 0); SG_LOAD(sa1, sb1, 1);
        SG_STORE(0, sa0, sb0); if (nkt > 2) SG_LOAD(sa0, sb0, 2); SG_SYNC();
        for (int kt = 0; kt < nkt; kt += 2) {
            SG_STORE(1, sa1, sb1);
            if (kt + 3 < nkt) SG_LOAD(sa1, sb1, kt + 3);
            SG_MMA(0);
            SG_SYNC();
            if (kt + 2 < nkt) SG_STORE(0, sa0, sb0);
            if (kt + 4 < nkt) SG_LOAD(sa0, sb0, kt + 4);
            SG_MMA(1);
            SG_SYNC();
        }
#undef SG_LOAD
#undef SG_STORE
#undef SG_SYNC
#undef SG_MMA
        const int row = row0 + 32 * wm + r32;
        float mu_ = 0.f, rstd_ = 1.f, ss_ = 0.f, qq_ = 0.f;
        if (Emit::NEEDS) { if (E.stp) { const pg8::f32x2e ms = pg8::stat_get(E.stp, row); mu_ = ms.x; rstd_ = ms.y; } }
#pragma unroll
        for (int r4 = 0; r4 < 4; ++r4) { const f32x4 v = {acc[4 * r4 + 0], acc[4 * r4 + 1], acc[4 * r4 + 2], acc[4 * r4 + 3]}; const f32x4 r = E(row, n0 + 32 * wn + 8 * r4 + 4 * hh, v, mu_, rstd_);
            if (Emit::STATS) { ss_ += (r[0] + r[1]) + (r[2] + r[3]); qq_ += (r[0] * r[0] + r[1] * r[1]) + (r[2] * r[2] + r[3] * r[3]); } }
        if (Emit::STATS) { ss_ += __shfl_xor(ss_, 32); qq_ += __shfl_xor(qq_, 32); atomicAdd(E.stn + 2 * (size_t)row + hh, hh ? qq_ : ss_); }
    }
}


constexpr int SW_P = 144, SW_ABYTES = 128 * SW_P, SW_BBYTES = 256 * SW_P, SW_BUF = SW_ABYTES + SW_BBYTES;
static_assert(2 * SW_BUF <= RING_BYTES, "wide small GEMM LDS");
template <class Emit> __device__ __forceinline__ void small_gemm_wide(const Ctx& C, const bf16* Ag, const bf16* Bt, int N, int K, int first, int stride, const Emit& E) {
    LAS unsigned char* const L = C.L; const int tid = C.tid, lane = C.lane, wave = C.wave;
    const int r32 = lane & 31, hh = lane >> 5, wm = wave >> 2, wn = wave & 3;
    const int nN = N / 256, nunits = (NSMP / 128) * nN, nkt = K / 64;
    const int prow = tid >> 3, pch = tid & 7;
    for (int u = first; u < nunits; u += stride) {
        const int mt = u / nN, nt = u - mt * nN; const int row0 = TP + mt * 128, n0 = nt * 256;
        const bf16* ag = Ag + (size_t)(row0 + prow) * K + pch * 8; const bf16* bg = Bt + (size_t)(n0 + prow) * K + pch * 8;
        v4u sa0[2], sb0[4], sa1[2], sb1[4];
#define SW_LOAD(sa_, sb_, kt_) do { _Pragma("unroll") for (int i_ = 0; i_ < 2; ++i_) sa_[i_] = *(const v4u*)(ag + (size_t)(64 * i_) * K + (kt_) * 64); \
        _Pragma("unroll") for (int i_ = 0; i_ < 4; ++i_) sb_[i_] = *(const v4u*)(bg + (size_t)(64 * i_) * K + (kt_) * 64); } while (0)
#define SW_STORE(buf_, sa_, sb_) do { LAS unsigned char* B_ = L + (buf_) * SW_BUF; _Pragma("unroll") for (int i_ = 0; i_ < 2; ++i_) *(LAS v4u*)(B_ + (prow + 64 * i_) * SW_P + pch * 16) = sa_[i_]; \
        _Pragma("unroll") for (int i_ = 0; i_ < 4; ++i_) *(LAS v4u*)(B_ + SW_ABYTES + (prow + 64 * i_) * SW_P + pch * 16) = sb_[i_]; } while (0)
#define SW_SYNC() do { asm volatile("s_waitcnt lgkmcnt(0)" ::: "memory"); __builtin_amdgcn_s_barrier(); asm volatile("" ::: "memory"); } while (0)
#define SW_MMA(buf_) do { const LAS unsigned char* AB_ = L + (buf_) * SW_BUF + (64 * wm + r32) * SW_P + 16 * hh; const LAS unsigned char* BB_ = L + (buf_) * SW_BUF + SW_ABYTES + (64 * wn + r32) * SW_P + 16 * hh; \
        _Pragma("unroll") for (int ks = 0; ks < 4; ++ks) { const bf16x8 a0_ = *(const LAS bf16x8*)(AB_ + 32 * ks), a1_ = *(const LAS bf16x8*)(AB_ + 32 * SW_P + 32 * ks), w0_ = *(const LAS bf16x8*)(BB_ + 32 * ks), w1_ = *(const LAS bf16x8*)(BB_ + 32 * SW_P + 32 * ks); \
            acc[0][0] = __builtin_amdgcn_mfma_f32_32x32x16_bf16(w0_, a0_, acc[0][0], 0, 0, 0); acc[0][1] = __builtin_amdgcn_mfma_f32_32x32x16_bf16(w1_, a0_, acc[0][1], 0, 0, 0); \
            acc[1][0] = __builtin_amdgcn_mfma_f32_32x32x16_bf16(w0_, a1_, acc[1][0], 0, 0, 0); acc[1][1] = __builtin_amdgcn_mfma_f32_32x32x16_bf16(w1_, a1_, acc[1][1], 0, 0, 0); } } while (0)
        f32x16 acc[2][2];
#pragma unroll
        for (int a_ = 0; a_ < 2; ++a_)
#pragma unroll
            for (int b_ = 0; b_ < 2; ++b_)
#pragma unroll
                for (int r = 0; r < 16; ++r) acc[a_][b_][r] = 0.f;
        SW_LOAD(sa0, sb0, 0); SW_LOAD(sa1, sb1, 1);
        SW_STORE(0, sa0, sb0); if (nkt > 2) SW_LOAD(sa0, sb0, 2); SW_SYNC();
        for (int kt = 0; kt < nkt; kt += 2) {
            SW_STORE(1, sa1, sb1);
            if (kt + 3 < nkt) SW_LOAD(sa1, sb1, kt + 3);
            SW_MMA(0);
            SW_SYNC();
            if (kt + 2 < nkt) SW_STORE(0, sa0, sb0);
            if (kt + 4 < nkt) SW_LOAD(sa0, sb0, kt + 4);
            SW_MMA(1);
            SW_SYNC();
        }
#undef SW_LOAD
#undef SW_STORE
#undef SW_SYNC
#undef SW_MMA
#pragma unroll
        for (int tb = 0; tb < 2; ++tb) { const int row = row0 + 64 * wm + 32 * tb + r32;
            float mu_ = 0.f, rstd_ = 1.f;
            if (Emit::NEEDS) { if (E.stp) { const pg8::f32x2e ms = pg8::stat_get(E.stp, row); mu_ = ms.x; rstd_ = ms.y; } }
#pragma unroll
            for (int cb = 0; cb < 2; ++cb)
#pragma unroll
                for (int r4 = 0; r4 < 4; ++r4) { const f32x4 v = {acc[tb][cb][4 * r4 + 0], acc[tb][cb][4 * r4 + 1], acc[tb][cb][4 * r4 + 2], acc[tb][cb][4 * r4 + 3]}; (void)E(row, n0 + 64 * wn + 32 * cb + 8 * r4 + 4 * hh, v, mu_, rstd_); } }
    }
}

__device__ __forceinline__ void y_phase(const Ctx& C, const bf16* Rb, const float* st, const float* gam, const float* bet, float* y) {
    const int lane = __builtin_amdgcn_mbcnt_hi(~0u, __builtin_amdgcn_mbcnt_lo(~0u, 0u));
    int row = C.gw;
    pg8::f32x2e ms = {0.f, 0.f}; v4u w[4];
    if (row < NTOK) { ms = pg8::stat_get(st, row); const v4u* rr = (const v4u*)(Rb + (size_t)row * DM) + lane;
#pragma unroll
        for (int j = 0; j < 4; ++j) w[j] = rr[64 * j]; }
    while (row < NTOK) {
        const int nrow = row + C.NGW; pg8::f32x2e nms = ms; v4u nw[4];
#pragma unroll
        for (int j = 0; j < 4; ++j) nw[j] = w[j];
        if (nrow < NTOK) { nms = pg8::stat_get(st, nrow); const v4u* rr = (const v4u*)(Rb + (size_t)nrow * DM) + lane;
#pragma unroll
            for (int j = 0; j < 4; ++j) nw[j] = rr[64 * j]; }
#pragma unroll
        for (int j = 0; j < 4; ++j) { const v4u ww = w[j]; const int c = 8 * (lane + 64 * j);
            const f32x4 v0 = {bflo(ww.x), bfhi(ww.x), bflo(ww.y), bfhi(ww.y)}, v1 = {bflo(ww.z), bfhi(ww.z), bflo(ww.w), bfhi(ww.w)};
            *(f32x4*)(y + (size_t)row * DM + c) = (v0 - ms.x) * ms.y * *(const f32x4*)(gam + c) + *(const f32x4*)(bet + c);
            *(f32x4*)(y + (size_t)row * DM + c + 4) = (v1 - ms.x) * ms.y * *(const f32x4*)(gam + c + 4) + *(const f32x4*)(bet + c + 4); }
        row = nrow; ms = nms;
#pragma unroll
        for (int j = 0; j < 4; ++j) w[j] = nw[j];
    }
}

namespace pg8 { struct AffineOrder { int n, pm0, dpm, pn0, dpn = 0;
    __device__ __forceinline__ bool next(int i, Unit& u) const { if (i >= n) return false; int pm_ = pm0 + dpm * i, pn_ = pn0 + dpn * i; asm volatile("" : "+s"(pm_), "+s"(pn_)); u.pm = pm_; u.pn = pn_; return true; }
    __device__ __forceinline__ void a_ready(const Unit&) const {}
    __device__ __forceinline__ void done(const Unit&) const {} }; }
__device__ __forceinline__ void mrg_arrive(unsigned* cnt) {
    asm volatile("s_waitcnt vmcnt(0)" ::: "memory"); __syncthreads();
    if (threadIdx.x == 0) { __builtin_amdgcn_fence(__ATOMIC_RELEASE, "agent"); asm volatile("s_waitcnt vmcnt(0)" ::: "memory"); (void)xb_add(cnt, 1u); }
}
__device__ __forceinline__ void mrg_arrive_xcd(unsigned* loc, unsigned* cnt, const XcdBarrier& b) {
    asm volatile("s_waitcnt vmcnt(0)" ::: "memory"); __syncthreads();
    if (threadIdx.x == 0) {
        const unsigned nloc = b.st[0];
        const unsigned old = xb_add(loc + 64 * b.x, 1u);
        if (old + 1u == nloc) { __builtin_amdgcn_fence(__ATOMIC_RELEASE, "agent"); asm volatile("s_waitcnt vmcnt(0)" ::: "memory"); (void)xb_add(cnt, nloc); }
    }
}
__device__ __forceinline__ void mrg_wait(unsigned* cnt, unsigned need, unsigned* bar) {
    if (threadIdx.x == 0) { XB_SPIN(xb_ld(cnt) < need, bar); __builtin_amdgcn_fence(__ATOMIC_ACQUIRE, "agent"); asm volatile("s_waitcnt vmcnt(0)" ::: "memory"); }
    __syncthreads();
}

template <int LAYER> __device__ __forceinline__ void layer_phases(const Ctx& C, const XcdBarrier& bar) {
    constexpr int PH_OUT = LAYER ? 14 : 5, PH_T = LAYER ? 15 : 6;
    LAS unsigned char* const L = C.L; const int G = C.G, bx = C.bx; const int vcu = (G % 8 == 0) ? (bx % 8) * (G / 8) + bx / 8 : bx;
#define STATP(i) (WSP(float, WS_STAT) + (size_t)(i) * NTOK * 2)
#define LNG(idx) (INP(float, idx) + LAYER * DM)
    constexpr size_t R_MIX = LAYER ? WS_X : WS_R, R_MLP = LAYER ? WS_R : WS_X, R_PLE = LAYER ? WS_X : WS_R;
    constexpr size_t B_MIX = LAYER ? WS_XB : WS_G, B_MLP = LAYER ? WS_G : WS_XB, B_PLE = LAYER ? WS_XB : WS_G;
    constexpr int S_MIX = 3 * LAYER, S_MLP = 3 * LAYER + 1, S_PLE = 3 * LAYER + 2;
    if (LAYER == 0) {
        if (IN(4)) {
            KArgs A = kargs(); unsigned char* ws = A->ws;
            pg8::Gemm g{WSP(bf16, WS_G), WSP(bf16, WS_WG), TP, DM, DM}; pg8::StaticOrder S; S.init(TP, DM, G, bx);
            pg8::EpiGate E{WSP(bf16, WS_G), WSP(bf16, WS_T), DM};
            pg8::gemm_phase<pg8::EpiGate, pg8::StaticOrder, true, true>(L + RING_OFF, g, S, E);
            small_gemm(C, WSP(bf16, WS_G), WSP(bf16, WS_WG), DM, DM, vcu, G, SEmitGate{WSP(bf16, WS_G), WSP(bf16, WS_T), nullptr, nullptr});
            SEAM(4);
        }
    } else {
        if (IN(12) && G != 256) {
            KArgs A = kargs(); unsigned char* ws = A->ws; float* out = A->out;
            const float* st = STATP(2); const float* cq = WSP(float, WS_CV) + CV_KVQ;
            pg8::Gemm g{WSP(bf16, WS_G), WSP(bf16, WS_WKVQ), TP, 3072, DM}; pg8::StaticOrder S; S.init(TP, 3072, G, bx);
            pg8::EpiKVQ E{out + O_K_P, out + O_V_P, WSP(bf16, WS_KB), WSP(bf16, WS_VT), WSP(bf16, WS_QB), st, cq, cq + 3072, QSCALE};
            pg8::gemm_phase<pg8::EpiKVQ, pg8::StaticOrder, true, true>(L + RING_OFF, g, S, E);
            { const bool spl = (G == 256);
              if (!spl || bx >= 128) small_gemm(C, WSP(bf16, WS_G), WSP(bf16, WS_WKVQ), 3072, DM, spl ? (bx % 8) * 16 + (bx - 128) / 8 : bx, spl ? 128 : G, SEmitKVQ{out + O_K_S, out + O_V_S, WSP(bf16, WS_QB), st, cq, cq + 3072, nullptr}); }
            SEAM(12);
        }
        if (IN(13)) { if (G == 256) attn_phase_dealt(C); else { attn_prompt_phase(C); attn_sample_phase(C); } SEAM(13); }
    }
    if (IN(PH_OUT)) {
        KArgs A = kargs(); unsigned char* ws = A->ws;
        pg8::Gemm g{LAYER ? WSP(bf16, WS_OB) : WSP(bf16, WS_T), LAYER ? WSP(bf16, WS_WO) : WSP(bf16, WS_WO5), TP, DM, DM}; pg8::StaticOrder S; S.init(TP, DM, G, bx);
        const float* xlo = INP(float, 0); const float* xhi = INP(float, 1) - (size_t)TP * DM; const bf16* xbp = WSP(bf16, WS_G);
        const float* stp = LAYER ? STATP(2) : nullptr; const float* gp = INP(float, 32); const float* bp = INP(float, 33);
        pg8::EpiRes E{xlo, xhi, xbp, stp, gp, bp, nullptr, WSP(bf16, B_MIX), STATP(S_MIX), DM, DN_ALPHA};
        pg8::gemm_phase<pg8::EpiRes, pg8::StaticOrder, true, true>(L + RING_OFF, g, S, E);
        small_gemm(C, LAYER ? WSP(bf16, WS_OB) : WSP(bf16, WS_T), LAYER ? WSP(bf16, WS_WO) : WSP(bf16, WS_WO5), DM, DM, vcu, G, SEmitRes{xhi, xbp, stp, gp, bp, nullptr, WSP(bf16, B_MIX), STATP(S_MIX)});
        SEAM(PH_OUT);
    }
    if (IN(PH_T + 1)) {
        KArgs A = kargs(); unsigned char* ws = A->ws;
        const float* cm = WSP(float, WS_CV) + (LAYER ? CV_M1_1 : CV_M1_0);
        const int x = bx & 7, r = bx >> 3; const bool special = r >= 28;
        unsigned* cntA = (unsigned*)(ws + WS_CTL) + CW_MRG + LAYER * 128; unsigned* cntB = cntA + 64;
        pg8::Gemm g1{WSP(bf16, B_MIX), WSP(bf16, LAYER ? WS_W1_1 : WS_W1_0), NTOK, DFF, DM};
        pg8::EpiAct<1> E1{WSP(bf16, WS_H), DFF, STATP(S_MIX), cm, cm + DFF};
        unsigned* locA = (unsigned*)(ws + WS_CTL) + CW_MRGL + LAYER * 2048; unsigned* locB = locA + 1024;
        unsigned* spec = (unsigned*)(ws + WS_CTL) + CW_MRGL + 8192 + LAYER * 1024;
        if (special && threadIdx.x == 0) (void)xb_add(spec + 64 * bar.x, 1u);
        { pg8::AffineOrder S{1, r & 7, 0, 4 * x + (r >> 3)}; pg8::gemm_phase<pg8::EpiAct<1>, pg8::AffineOrder, true, true>(L + RING_OFF, g1, S, E1); }
        if (special && threadIdx.x == 0) { const unsigned nloc_ = bar.st[0]; XB_SPIN(xb_ld(locA + 64 * bar.x) + xb_ld(spec + 64 * bar.x) < nloc_, bar.bar); }
        mrg_arrive_xcd(locA, cntA, bar);
        if (!special) { pg8::AffineOrder S{4, 8 + r % 7, 7, 4 * x + r / 7}; pg8::gemm_phase<pg8::EpiAct<1>, pg8::AffineOrder, true, true>(L + RING_OFF, g1, S, E1); }
        mrg_arrive_xcd(locB, cntB, bar);
        mrg_wait(special ? cntA : cntB, (unsigned)G, bar.bar);
        pg8::Gemm g2{WSP(bf16, WS_H), WSP(bf16, LAYER ? WS_W2_1 : WS_W2_0), NTOK, DM, DFF};
        pg8::EpiRes E2{nullptr, nullptr, WSP(bf16, B_MIX), STATP(S_MIX), LNG(24), LNG(25), nullptr, WSP(bf16, B_MLP), STATP(S_MLP), DM, DN_ALPHA};
        { pg8::AffineOrder S; S.n = special ? 2 : 1; S.pm0 = special ? 2 * (x >> 1) : 8 + 7 * (x >> 1) + r % 7; S.dpm = 1; S.pn0 = 4 * (x & 1) + (special ? r - 28 : r / 7);
          pg8::gemm_phase<pg8::EpiRes, pg8::AffineOrder, true, true>(L + RING_OFF, g2, S, E2); }
        SEAM(PH_T + 1);
    }
    if (LAYER == 0 && G == 256) { if (IN(PH_T + 4)) {
#define PK_PLE(order_) do { KArgs A = kargs(); unsigned char* ws = A->ws; const float* cp = WSP(float, WS_CV) + CV_PL_0; \
            pg8::Gemm gP{WSP(bf16, B_MLP), WSP(bf16, WS_WPG_0), NTOK, DM, DM}; \
            pg8::EpiPle EP{WSP(bf16, B_MLP), WSP(bf16, WS_E0), STATP(S_MLP), LNG(28), LNG(29), cp, cp + DM, nullptr, WSP(bf16, B_PLE), STATP(S_PLE), DM, DN_ALPHA}; \
            pg8::AffineOrder S = order_; pg8::gemm_phase<pg8::EpiPle, pg8::AffineOrder, true, true>(L + RING_OFF, gP, S, EP); } while (0)
#define PK_KVQ(order_) do { KArgs A = kargs(); unsigned char* ws = A->ws; float* out = A->out; const float* cq = WSP(float, WS_CV) + CV_KVQ; \
            pg8::Gemm gK{WSP(bf16, WS_G), WSP(bf16, WS_WKVQ), NTOK, 3072, DM}; \
            pg8::EpiKVQ EK{out + O_K_P, out + O_V_P, WSP(bf16, WS_KB), WSP(bf16, WS_VT), WSP(bf16, WS_QB), STATP(2), cq, cq + 3072, QSCALE}; \
            pg8::AffineOrder S = order_; pg8::gemm_phase<pg8::EpiKVQ, pg8::AffineOrder, true, true>(L + RING_OFF, gK, S, EK); } while (0)
#define PK_KVQS(order_) do { KArgs A = kargs(); unsigned char* ws = A->ws; float* out = A->out; const float* cq = WSP(float, WS_CV) + CV_KVQ; \
            pg8::Gemm gK{WSP(bf16, WS_G), WSP(bf16, WS_WKVQ), NTOK, 3072, DM}; \
            pg8::EpiKVQS EK{out + O_K_S, out + O_V_S, WSP(bf16, WS_QB), STATP(2), cq, cq + 3072, QSCALE}; \
            pg8::AffineOrder S = order_; pg8::gemm_phase<pg8::EpiKVQS, pg8::AffineOrder, true, true>(L + RING_OFF, gK, S, EK); } while (0)
#define PK_CNT(i_) ((unsigned*)(kargs()->ws + WS_CTL) + CW_MRG + 256 + 64 * (i_))
#define PK_LOC(i_) ((unsigned*)(kargs()->ws + WS_CTL) + CW_MRGL + 4096 + 1024 * (i_))
        { const int x = bx & 7, r = bx >> 3; PK_PLE((pg8::AffineOrder{1, 8 * (x >> 1) + (r & 7), 0, 4 * (x & 1) + (r >> 3), 0})); }
        mrg_arrive_xcd(PK_LOC(0), PK_CNT(0), bar);
        if ((bx >> 3) >= 28) { { const int x = bx & 7, r = bx >> 3; PK_PLE((pg8::AffineOrder{1, 32 + (r - 28), 0, x, 0})); } }
        mrg_arrive_xcd(PK_LOC(1), PK_CNT(1), bar);
        mrg_wait(PK_CNT(0), 256u, bar.bar);
        {
            const int x = bx & 7, r = bx >> 3; PK_KVQ((pg8::AffineOrder{(r < 16) ? 2 : 1, 8 * (x >> 1) + (r & 7), 0, 6 * (x & 1) + (r >> 3), 4})); }
        if ((bx >> 3) >= 16 && (bx >> 3) < 22) {
            mrg_wait(PK_CNT(1), 256u, bar.bar);
            const int v = 6 * (bx & 7) + ((bx >> 3) - 16); PK_KVQS((pg8::AffineOrder{1, 32 + (v & 3), 0, v >> 2, 0})); }
#undef PK_PLE
#undef PK_KVQ
#undef PK_KVQS
#undef PK_CNT
#undef PK_LOC
        SEAM(PH_T + 4);
    } } else
    if (IN(PH_T + 4)) {
        KArgs A = kargs(); unsigned char* ws = A->ws;
        const float* cp = WSP(float, WS_CV) + (LAYER ? CV_PL_1 : CV_PL_0);
        pg8::Gemm g{WSP(bf16, B_MLP), WSP(bf16, LAYER ? WS_WPG_1 : WS_WPG_0), TP, DM, DM}; pg8::StaticOrder S; S.init(TP, DM, G, bx);
        pg8::EpiPle E{WSP(bf16, B_MLP), WSP(bf16, LAYER ? WS_E1 : WS_E0), STATP(S_MLP), LNG(28), LNG(29), cp, cp + DM, nullptr, WSP(bf16, B_PLE), STATP(S_PLE), DM, DN_ALPHA};
        pg8::gemm_phase<pg8::EpiPle, pg8::StaticOrder, true, true>(L + RING_OFF, g, S, E);
        small_gemm(C, WSP(bf16, B_MLP), WSP(bf16, LAYER ? WS_WPG_1 : WS_WPG_0), DM, DM, vcu, G, SEmitPle{WSP(bf16, B_MLP), WSP(bf16, LAYER ? WS_E1 : WS_E0), STATP(S_MLP), LNG(28), LNG(29), cp, cp + DM, nullptr, WSP(bf16, B_PLE), STATP(S_PLE)});
        SEAM(PH_T + 4);
    }
    if (LAYER == 1) { if (IN(PH_T + 5)) { KArgs A = kargs(); unsigned char* ws = A->ws; y_phase(C, WSP(bf16, B_PLE), STATP(S_PLE), LNG(32), LNG(33), A->out + O_Y); } }
#undef STATP
#undef LNG
}

__global__ void __launch_bounds__(NWAVES * 64, 2) skel_fwd(Args args) {
    extern __shared__ __attribute__((aligned(16))) unsigned char lds[];
    Ctx C; C.L = (LAS unsigned char*)lds;
    LAS unsigned char* const L = C.L;
    volatile LAS unsigned* const MISC = (volatile LAS unsigned*)(L + MISC_OFF);
    C.tid = threadIdx.x; C.lane = C.tid & 63; C.wave = __builtin_amdgcn_readfirstlane(C.tid >> 6);
    C.G = gridDim.x; C.bx = blockIdx.x; C.lo = args.ph_lo; C.hi = args.ph_hi;
    C.gw = C.wave * C.G + C.bx; C.NGW = C.G * NWAVES;
    const int tid = C.tid, lane = C.lane, wave = C.wave, G = C.G, bx = C.bx, gw = C.gw, NGW = C.NGW;
    const int vcu = (G % 8 == 0) ? (bx % 8) * (G / 8) + bx / 8 : bx;
    for (int u = tid; u < (LDS_BYTES - LDSCTL_OFF) / 4; u += NWAVES * 64) ((LAS unsigned*)(L + LDSCTL_OFF))[u] = 0u;
    __syncthreads();
    const bool use_bar = (C.hi - C.lo) > 1;
    XcdBarrier bar; bar.bar = (unsigned*)(args.ws + WS_CTL) + CW_BAR + args.li * XCD_BAR_WORDS; bar.x = 0; bar.st = nullptr;
    if (use_bar) bar = xcd_barrier_post((unsigned*)(args.ws + WS_CTL) + CW_BAR + args.li * XCD_BAR_WORDS, MISC + 8);

    if (IN(0)) {
        KArgs A = kargs(); unsigned char* ws = A->ws;
        LAS float* scr = (LAS float*)(L + RING_OFF + wave * 16384);
        constexpr int I_SQ = (DM / 64) * (DM / 32), I_W1 = (DM / 64) * (DFF / 32), I_W2 = (DFF / 64) * (DM / 32), I_PP = (PLED / 64) * (DM / 32), I_KV = (DM / 64) * (512 / 32);
        constexpr int PER_L = I_W1 + I_W2 + I_PP + I_SQ;
        constexpr int NITEMS = 4 * I_SQ + 2 * I_KV + 2 * PER_L;
        for (int it = gw; it < NITEMS; it += NGW) {
            int r = it;
            if (r < I_SQ) { p0_transpose_item(INP(float, 17), DM, DM, WSP(bf16, WS_WG), 0, scr, r, lane); continue; } r -= I_SQ;
            if (r < I_SQ) { p0_transpose_item(INP(float, 18), DM, DM, WSP(bf16, WS_WO5), 0, scr, r, lane); continue; } r -= I_SQ;
            { const float* gq = INP(float, 32); const float* bq = INP(float, 33); float* cq = WSP(float, WS_CV) + CV_KVQ;
            if (r < I_KV) { p0_transpose_item(INP(float, 19), DM, 512, WSP(bf16, WS_WKVQ), 0, scr, r, lane, gq, bq, cq, cq + 3072); continue; } r -= I_KV;
            if (r < I_KV) { p0_transpose_item(INP(float, 20), DM, 512, WSP(bf16, WS_WKVQ), 512, scr, r, lane, gq, bq, cq, cq + 3072); continue; } r -= I_KV;
            if (r < I_SQ) { p0_transpose_item(INP(float, 21), DM, DM, WSP(bf16, WS_WKVQ), 1024, scr, r, lane, gq, bq, cq, cq + 3072); continue; } r -= I_SQ; }
            if (r < I_SQ) { p0_transpose_item(INP(float, 22), DM, DM, WSP(bf16, WS_WO), 0, scr, r, lane); continue; } r -= I_SQ;
            const int l = r / PER_L; r -= l * PER_L;
            if (r < I_W1) { float* cm = WSP(float, WS_CV) + (l ? CV_M1_1 : CV_M1_0);
                p0_transpose_item(INP(float, 26) + (size_t)l * DM * DFF, DM, DFF, WSP(bf16, l ? WS_W1_1 : WS_W1_0), 0, scr, r, lane, INP(float, 24) + l * DM, INP(float, 25) + l * DM, cm, cm + DFF); continue; } r -= I_W1;
            if (r < I_W2) { p0_transpose_item(INP(float, 27) + (size_t)l * DM * DFF, DFF, DM, WSP(bf16, l ? WS_W2_1 : WS_W2_0), 0, scr, r, lane); continue; } r -= I_W2;
            if (r < I_PP) { p0_transpose_item(INP(float, 30) + (size_t)l * PLED * DM, PLED, DM, WSP(bf16, l ? WS_WPP_1 : WS_WPP_0), 0, scr, r, lane); continue; } r -= I_PP;
            { float* cp = WSP(float, WS_CV) + (l ? CV_PL_1 : CV_PL_0);
              p0_transpose_item(INP(float, 31) + (size_t)l * DM * DM, DM, DM, WSP(bf16, l ? WS_WPG_1 : WS_WPG_0), 0, scr, r, lane, INP(float, 28) + l * DM, INP(float, 29) + l * DM, cp, cp + DM); }
        }
        const float* p_prompt = INP(float, 2); const float* p_sample = INP(float, 3); bf16* Pb = WSP(bf16, WS_PB);
        for (int i = bx * 512 + tid; i < 2 * NTOK * PLED / 4; i += G * 512) {
            const int l = i / (NTOK * PLED / 4), rem = i % (NTOK * PLED / 4), row = rem / (PLED / 4), c4 = rem % (PLED / 4);
            const float* src = row < TP ? p_prompt + ((size_t)l * TP + row) * PLED + 4 * c4 : p_sample + ((size_t)l * NSMP + (row - TP)) * PLED + 4 * c4;
            const f32x4 v = *(const f32x4*)src; unsigned long long o = (unsigned long long)pk2(v.x, v.y) | ((unsigned long long)pk2(v.z, v.w) << 32);
            *(unsigned long long*)(Pb + ((size_t)l * NTOK + row) * PLED + 4 * c4) = o;
        }
        __syncthreads();
    }

    if (IN(1)) {
        KArgs A = kargs(); unsigned char* ws = A->ws; float* Sloc = WSP(float, WS_HS); const float* x_prompt = INP(float, 0);
        LAS float* tile = (LAS float*)(L + RING_OFF + wave * S5_WAVE_LDS);
        const int tk = lane & 15, kq = lane >> 4;
        f32x4s P; bf16x8 bop[16], cop_unused[8];
        s5_operands<false>(A, bx & 127, lane, tile + 16 * S5_TS, P, bop, cop_unused);
        for (int it = gw; it < NG * (S5_NCH - 1); it += NGW) {
            const int g = it & 127, c = it >> 7;
            float hr = 0.f, hi_ = 0.f;
            const float* xl = x_prompt + (size_t)(c * S5_L + tk) * DM + g * 16 + 8 * (kq & 1);
            f32x4 xa0 = *(const f32x4*)xl, xa1 = *(const f32x4*)(xl + 4);
            for (int sb = 0; sb < S5_SB; ++sb) {
                const bf16x8 aop = s5_aop(xa0, xa1, kq);
                if (sb + 1 < S5_SB) { xa0 = *(const f32x4*)(xl + (size_t)(sb + 1) * 16 * DM); xa1 = *(const f32x4*)(xl + (size_t)(sb + 1) * 16 * DM + 4); }
                s5_bu(aop, bop, tile, lane);
#pragma unroll
                for (int s2 = 0; s2 < 16; ++s2) { const float br = tile[s2 * S5_TS + lane], bi = tile[s2 * S5_TS + 64 + lane]; const float nr = P[0] * hr - P[1] * hi_ + br, ni = P[0] * hi_ + P[1] * hr + bi; hr = nr; hi_ = ni; }
            }
            Sloc[((size_t)c * NG + g) * 128 + lane] = hr; Sloc[((size_t)c * NG + g) * 128 + 64 + lane] = hi_;
        }
        SEAM(1);
    }

    if (IN(2)) {
        KArgs A = kargs(); unsigned char* ws = A->ws; float* out = A->out; const float* Sloc = WSP(float, WS_HS); bf16* Gb = WSP(bf16, WS_G);
        const float* x_prompt = INP(float, 0); const float* x_sample = INP(float, 1); const float* st_re = INP(float, 4); const float* st_im = INP(float, 5); const float* s5_d = INP(float, 16);
        LAS float* tile = (LAS float*)(L + RING_OFF + wave * S5_WAVE_LDS);
        const int tk = lane & 15, kq = lane >> 4;
        f32x4s P; bf16x8 bop[16], cop[8];
        s5_operands<true>(A, bx & 127, lane, tile + 16 * S5_TS, P, bop, cop);
        constexpr int NPI = NG * S5_NCH, NSI = NG * (DECB / 16);
        for (int it = gw; it < NPI + NSI; it += NGW) {
            const bool isp = it < NPI; const int g = it & 127; const int c = isp ? (it >> 7) : 0; const int bq = isp ? 0 : ((it - NPI) >> 7);
            const float dcol = s5_d[g * 16 + tk];
            float hr = 0.f, hi_ = 0.f;
            if (isp) {
                for (int j0 = 0; j0 < c; j0 += 8) {
                    float sr[8], si[8];
#pragma unroll
                    for (int u = 0; u < 8; ++u) { int j = j0 + u; j = j < c ? j : c - 1; sr[u] = Sloc[((size_t)j * NG + g) * 128 + lane]; si[u] = Sloc[((size_t)j * NG + g) * 128 + 64 + lane]; }
#pragma unroll
                    for (int u = 0; u < 8; ++u) { if (j0 + u < c) { const float nr = P[2] * hr - P[3] * hi_ + sr[u], ni = P[2] * hi_ + P[3] * hr + si[u]; hr = nr; hi_ = ni; } }
                } }
            const int nsb = isp ? S5_SB : 8; const int row0 = isp ? c * S5_L : TP + bq * 128;
            const float* xb = (isp ? x_prompt + (size_t)row0 * DM : x_sample + (size_t)(row0 - TP) * DM) + g * 16;
            const float* xl = xb + (size_t)tk * DM + 8 * (kq & 1);
            const float* xe = xb + (size_t)(4 * kq) * DM + tk;
            f32x4 xa0 = *(const f32x4*)xl, xa1 = *(const f32x4*)(xl + 4);
            float xv[4];
#pragma unroll
            for (int i = 0; i < 4; ++i) xv[i] = xe[(size_t)i * DM];
            for (int sb = 0; sb < nsb; ++sb) {
                const int rowb = row0 + sb * 16;
                const bf16x8 aop = s5_aop(xa0, xa1, kq);
                float xc[4];
#pragma unroll
                for (int i = 0; i < 4; ++i) xc[i] = xv[i];
                if (sb + 1 < nsb) { const size_t o = (size_t)(sb + 1) * 16 * DM; xa0 = *(const f32x4*)(xl + o); xa1 = *(const f32x4*)(xl + o + 4);
#pragma unroll
                    for (int i = 0; i < 4; ++i) xv[i] = xe[o + (size_t)i * DM]; }
                s5_bu(aop, bop, tile, lane);
                const size_t sb0 = ((size_t)(16 * bq + 2 * sb) * NG + g) * 64 + lane;
                if (!isp) { hr = st_re[sb0]; hi_ = st_im[sb0]; }
#pragma unroll
                for (int s2 = 0; s2 < 16; ++s2) {
                    if (s2 == 8 && !isp) { out[O_SRE_S + sb0] = hr; out[O_SIM_S + sb0] = hi_; hr = st_re[sb0 + NG * 64]; hi_ = st_im[sb0 + NG * 64]; }
                    const float br = tile[s2 * S5_TS + lane], bi = tile[s2 * S5_TS + 64 + lane]; const float nr = P[0] * hr - P[1] * hi_ + br, ni = P[0] * hi_ + P[1] * hr + bi; hr = nr; hi_ = ni;
                    tile[s2 * S5_TS + lane] = hr; tile[s2 * S5_TS + 64 + lane] = hi_;
                }
                if (!isp) { out[O_SRE_S + sb0 + NG * 64] = hr; out[O_SIM_S + sb0 + NG * 64] = hi_; }
                f32x4s ya = {0.f, 0.f, 0.f, 0.f}, yb = {0.f, 0.f, 0.f, 0.f};
#pragma unroll
                for (int ks = 0; ks < 4; ++ks) {
                    const LAS f32x4* hp = (const LAS f32x4*)(tile + tk * S5_TS + 32 * ks + 8 * kq); const f32x4 h0 = hp[0], h1 = hp[1];
                    v4u hh_; hh_.x = hi_pair(h0.x, h0.y); hh_.y = hi_pair(h0.z, h0.w); hh_.z = hi_pair(h1.x, h1.y); hh_.w = hi_pair(h1.z, h1.w);
                    v4u hl_; hl_.x = lo_pair(h0.x, h0.y, hh_.x); hl_.y = lo_pair(h0.z, h0.w, hh_.y); hl_.z = lo_pair(h1.x, h1.y, hh_.z); hl_.w = lo_pair(h1.z, h1.w, hh_.w);
                    const bf16x8 ah = __builtin_bit_cast(bf16x8, hh_), al = __builtin_bit_cast(bf16x8, hl_);
                    ya = __builtin_amdgcn_mfma_f32_16x16x32_bf16(ah, cop[2 * ks], ya, 0, 0, 0);
                    yb = __builtin_amdgcn_mfma_f32_16x16x32_bf16(al, cop[2 * ks], yb, 0, 0, 0);
                    ya = __builtin_amdgcn_mfma_f32_16x16x32_bf16(ah, cop[2 * ks + 1], ya, 0, 0, 0);
                }
                const f32x4s y = ya + yb;
#pragma unroll
                for (int i = 0; i < 4; ++i) { const float v = y[i] + dcol * xc[i]; Gb[(size_t)(rowb + 4 * kq + i) * DM + g * 16 + tk] = (bf16)cvtpk(gelu_tanh(v), 0.f); }
            }
            if (isp && c == S5_NCH - 1) { out[O_SRE_P + g * 64 + lane] = hr; out[O_SIM_P + g * 64 + lane] = hi_; }
        }
        __syncthreads();
    }

    if (IN(3)) {
        { KArgs A = kargs(); unsigned char* ws = A->ws;
          pg8::Gemm g{WSP(bf16, WS_PB), WSP(bf16, WS_WPP_0), TP, DM, PLED}; pg8::StaticOrder S; S.init(TP, DM, G, bx);
          pg8::EpiAct<0> E{WSP(bf16, WS_E0), DM};
          pg8::gemm_phase<pg8::EpiAct<0>, pg8::StaticOrder, false, false>(L + RING_OFF, g, S, E);
          small_gemm(C, WSP(bf16, WS_PB), WSP(bf16, WS_WPP_0), DM, PLED, vcu, G, SEmitAct<0>{WSP(bf16, WS_E0), DM}); }
        __syncthreads();
        { KArgs A = kargs(); unsigned char* ws = A->ws;
          pg8::Gemm g{WSP(bf16, WS_PB) + (size_t)NTOK * PLED, WSP(bf16, WS_WPP_1), TP, DM, PLED}; pg8::StaticOrder S; S.init(TP, DM, G, bx);
          pg8::EpiAct<0> E{WSP(bf16, WS_E1), DM};
          pg8::gemm_phase<pg8::EpiAct<0>, pg8::StaticOrder, false, false>(L + RING_OFF, g, S, E);
          small_gemm(C, WSP(bf16, WS_PB) + (size_t)NTOK * PLED, WSP(bf16, WS_WPP_1), DM, PLED, vcu, G, SEmitAct<0>{WSP(bf16, WS_E1), DM}); }
        SEAM(3);
    }

    layer_phases<0>(C, bar);
    layer_phases<1>(C, bar);
}
#undef IN
#undef BOTH
#undef SEAM

constexpr int N_PHASES = 21;
#ifndef MK_N_LAUNCHES
#define MK_N_LAUNCHES 1
#endif
extern "C" void kernel_launch(void* const* d_in, const int* in_sizes, int n_in, void* d_out, int out_size, void* d_ws, size_t ws_size, hipStream_t stream) {
    static int grid = 0;
    if (grid == 0) {
        if (n_in != 34 || out_size != (int)O_END || ws_size < WS_END) { fprintf(stderr, "kernel_launch: unexpected shapes: n_in %d out %d ws %zu\n", n_in, out_size, ws_size); grid = -1; return; }
        int dev = 0, cus = 0, per_cu = 0;
        if (hipGetDevice(&dev) != hipSuccess || hipDeviceGetAttribute(&cus, hipDeviceAttributeMultiprocessorCount, dev) != hipSuccess) { grid = -1; return; }
        if (hipFuncSetAttribute((const void*)skel_fwd, hipFuncAttributeMaxDynamicSharedMemorySize, LDS_BYTES) != hipSuccess) { fprintf(stderr, "kernel_launch: hipFuncSetAttribute failed\n"); grid = -1; return; }
        if (hipOccupancyMaxActiveBlocksPerMultiprocessor(&per_cu, (const void*)skel_fwd, NWAVES * 64, LDS_BYTES) != hipSuccess || per_cu < 1) fprintf(stderr, "kernel_launch: occupancy query reports %d\n", per_cu);
        (void)hipGetLastError();
        grid = cus;
        if (grid != 256) { fprintf(stderr, "kernel_launch: the merged MLP deal is written for 256 workgroups (got %d CUs)\n", grid); grid = -1; return; }
        if (grid % 128 != 0) { fprintf(stderr, "kernel_launch: this build deals S5 groups by blockIdx %% 128 and needs a CU count that is a multiple of 128 (got %d)\n", grid); grid = -1; return; }
    }
    if (grid < 0) return;
    (void)hipMemsetAsync((char*)d_ws + WS_CTL, 0, CTL_ZERO_BYTES, stream);
    Args a{};
    for (int i = 0; i < 34; ++i) a.in[i] = d_in[i];
    a.out = (float*)d_out; a.ws = (unsigned char*)d_ws;
    constexpr int NL = MK_N_LAUNCHES;
    for (int li = 0; li < NL; ++li) {
        a.ph_lo = (NL == N_PHASES) ? li : (li * N_PHASES) / NL; a.ph_hi = (NL == N_PHASES) ? li + 1 : ((li + 1) * N_PHASES) / NL; a.li = li; a.pad = 0;
        hipLaunchKernelGGL(skel_fwd, dim3(grid), dim3(NWAVES * 64), LDS_BYTES, stream, a);
    }
}
```
